# Optimizing an MI355X kernel written in HIP

```python
import jax, jax.numpy as jnp
from jax import lax
import numpy as np

D_MODEL = 1024
BATCH = 8
SEQ = 4096
DEPTH = 1

PLE_DIM = 256
NORM_EPS = 1e-6
RW_HEADS = 8
RW_HEAD_DIM = 64
RW_WIDTH = RW_HEADS * RW_HEAD_DIM
DECAY_LORA = 64
AAA_LORA = 64
GATE_LORA = 160
RW_COLS = 3 * RW_WIDTH + DECAY_LORA + AAA_LORA + GATE_LORA
RW_LN_EPS = 64e-5
ATT_GROUPS = ((128, 1), (512, 4), (2048, 16))
ATT_HEADS_PER_GROUP = 4
ATT_HEADS = ATT_HEADS_PER_GROUP * len(ATT_GROUPS)
ATT_HEAD_DIM = 64
ATT_WIDTH = ATT_HEADS * ATT_HEAD_DIM
ATT_OUT = ATT_HEADS_PER_GROUP * ATT_HEAD_DIM
ATT_COLS = 3 * ATT_WIDTH
IN_COLS = RW_COLS + ATT_COLS
D_FF = 3 * D_MODEL
CONV_WIDTH = 3

kernel_name = "hybrid_rwkv7_dilated_alibi_convglu"


def rms_norm(x, g):
    xf = x.astype(jnp.float32)
    y = xf * lax.rsqrt(jnp.mean(xf * xf, axis=-1, keepdims=True) + NORM_EPS)
    return (y * g.astype(jnp.float32)).astype(x.dtype)


def shift_right(u, n):
    if n == 0:
        return u
    return jnp.pad(u, ((0, 0), (n, 0), (0, 0)))[:, :-n]


def alibi_slopes(n):
    return jnp.asarray(np.array([2.0 ** (-8.0 * (h + 1) / n) for h in range(n)], dtype=np.float32))


def rwkv7_time_mix(P, mu, w0, w_up, a0, a_up, g_up, k_k, k_a, r_k, ln_g, ln_b):
    B, T, _ = P.shape
    H, N = RW_HEADS, RW_HEAD_DIM
    Pm = P + (shift_right(P, 1) - P) * mu
    cuts = list(np.cumsum([RW_WIDTH, RW_WIDTH, RW_WIDTH, DECAY_LORA, AAA_LORA]))
    r, k, v, xw, xa, xg = jnp.split(Pm, cuts, axis=-1)
    w = -jax.nn.softplus(-(w0 + jnp.tanh(xw) @ w_up)) - 0.5
    decay = jnp.exp(-jnp.exp(w.astype(jnp.float32)))
    a = jax.nn.sigmoid(a0 + xa @ a_up)
    g = jax.nn.sigmoid(xg) @ g_up
    hs = lambda z: z.astype(jnp.float32).reshape(B, T, H, N)
    r, k, v, a, decay = hs(r), hs(k), hs(v), hs(a), hs(decay)
    kk = k * k_k.reshape(H, N)
    kk = kk / jnp.maximum(jnp.linalg.norm(kk, axis=-1, keepdims=True), 1e-12)
    k = k * (1.0 + (a - 1.0) * k_a.reshape(H, N))
    a_vec = -kk
    b_vec = kk * a

    def step(S, inp):
        r_t, w_t, k_t, v_t, a_t, b_t = inp
        Sa = jnp.einsum("bhvk,bhk->bhv", S, a_t)
        S = S * w_t[:, :, None, :] + Sa[..., None] * b_t[:, :, None, :] + v_t[..., None] * k_t[:, :, None, :]
        y = jnp.einsum("bhvk,bhk->bhv", S, r_t)
        return S, y

    tm = lambda z: jnp.swapaxes(z, 0, 1)
    S0 = jnp.zeros((B, H, N, N), jnp.float32)
    _, y = lax.scan(step, S0, (tm(r), tm(decay), tm(k), tm(v), tm(a_vec), tm(b_vec)))
    y = jnp.swapaxes(y, 0, 1)
    mean = jnp.mean(y, axis=-1, keepdims=True)
    var = jnp.mean(jnp.square(y - mean), axis=-1, keepdims=True)
    y = ((y - mean) * lax.rsqrt(var + RW_LN_EPS)).reshape(B, T, RW_WIDTH) * ln_g + ln_b
    bonus = (jnp.sum(r * k * r_k, axis=-1, keepdims=True) * v).reshape(B, T, RW_WIDTH)
    return ((y + bonus) * g).astype(P.dtype)


def dilated_group_attention(q, k, v, window, dilation, slopes):
    B, T, H, E = q.shape
    L = window // dilation
    span = L * dilation
    Tp = -(-T // span) * span
    pad = Tp - T
    nb = Tp // span

    def to_blocks(z):
        z = jnp.pad(z, ((0, 0), (0, pad), (0, 0), (0, 0)))
        return z.reshape(B, nb, L, dilation, H, E)

    def with_prev(z):
        zp = jnp.pad(z, ((0, 0), (1, 0), (0, 0), (0, 0), (0, 0), (0, 0)))[:, :-1]
        return jnp.concatenate([zp, z], axis=2)

    qb = to_blocks(q)
    kc = with_prev(to_blocks(k))
    vc = with_prev(to_blocks(v))
    s = jnp.einsum("bnqrhe,bnkrhe->bnrhqk", qb, kc).astype(jnp.float32) * (E ** -0.5)
    qi = jnp.arange(L)[:, None]
    kj = jnp.arange(2 * L)[None, :]
    steps = qi + L - kj
    blk = jnp.arange(nb)[:, None, None]
    valid = (steps >= 0) & (steps <= L) & (blk * L - L + kj >= 0)
    bias = -slopes[:, None, None] * (dilation * steps).astype(jnp.float32)[None]
    logits = jnp.where(valid[None, :, None, None], s + bias, -jnp.inf)
    lse = jax.nn.logsumexp(logits, axis=-1)
    prob = jnp.exp(logits - lse[..., None])
    o = jnp.einsum("bnrhqk,bnkrhe->bnqrhe", prob.astype(v.dtype), vc)
    o = o.reshape(B, Tp, H, E)[:, :T]
    lse = jnp.moveaxis(lse, 4, 2).reshape(B, Tp, H)[:, :T]
    return o, lse


def dilated_mixture_attention(P, slopes):
    B, T, _ = P.shape
    q, k, v = [z.reshape(B, T, ATT_HEADS, ATT_HEAD_DIM) for z in jnp.split(P, 3, axis=-1)]
    outs, lses = [], []
    for gi, (window, dilation) in enumerate(ATT_GROUPS):
        hsl = slice(gi * ATT_HEADS_PER_GROUP, (gi + 1) * ATT_HEADS_PER_GROUP)
        o, l = dilated_group_attention(q[:, :, hsl], k[:, :, hsl], v[:, :, hsl], window, dilation, slopes[hsl])
        outs.append(o.astype(jnp.float32))
        lses.append(l)
    wts = jax.nn.softmax(jnp.stack(lses, axis=0), axis=0)
    o = jnp.sum(wts[..., None] * jnp.stack(outs, axis=0), axis=0)
    return o.reshape(B, T, ATT_OUT).astype(P.dtype)


def conv_glu_ffn(h, w_up, conv_w, conv_b, w_down):
    u = h @ w_up
    u = conv_b + sum(conv_w[j] * shift_right(u, j) for j in range(CONV_WIDTH))
    gate, val = jnp.split(u, 2, axis=-1)
    return (jax.nn.gelu(gate, approximate=True) * val) @ w_down


def setup_inputs(seed: int = 0) -> dict:
    key = jax.random.key(seed)
    ks = jax.random.split(key, 32)
    Ld = DEPTH
    nrm = lambda kk, shape, fan: jax.random.normal(kk, shape, jnp.float32) * (fan ** -0.5)
    gain = lambda kk, n: 1.0 + 0.1 * jax.random.normal(kk, (Ld, n), jnp.float32)
    small = lambda kk, shape, s: s * jax.random.normal(kk, shape, jnp.float32)
    conv_w = jnp.array([1.0, 0.0, 0.0], jnp.float32)[None, :, None] + small(ks[22], (Ld, CONV_WIDTH, 2 * D_FF), 0.2)
    return {
        "x": jax.random.normal(ks[0], (BATCH, SEQ, D_MODEL), jnp.float32),
        "p": jax.random.normal(ks[1], (DEPTH, BATCH, SEQ, PLE_DIM), jnp.float32),
        "g_mix": gain(ks[2], D_MODEL),
        "w_in": nrm(ks[3], (Ld, D_MODEL, IN_COLS), D_MODEL),
        "rw_mu": jax.random.uniform(ks[4], (Ld, RW_COLS), jnp.float32),
        "rw_w0": jax.random.uniform(ks[5], (Ld, RW_WIDTH), jnp.float32, minval=-6.5, maxval=-1.5),
        "rw_w_up": 0.1 * nrm(ks[6], (Ld, DECAY_LORA, RW_WIDTH), DECAY_LORA),
        "rw_a0": small(ks[7], (Ld, RW_WIDTH), 0.1),
        "rw_a_up": nrm(ks[8], (Ld, AAA_LORA, RW_WIDTH), AAA_LORA),
        "rw_g_up": nrm(ks[9], (Ld, GATE_LORA, RW_WIDTH), GATE_LORA),
        "rw_k_k": 0.85 + small(ks[10], (Ld, RW_WIDTH), 0.05),
        "rw_k_a": 1.0 + small(ks[11], (Ld, RW_WIDTH), 0.05),
        "rw_r_k": small(ks[12], (Ld, RW_HEADS, RW_HEAD_DIM), 0.1),
        "rw_ln_g": gain(ks[13], RW_WIDTH),
        "rw_ln_b": small(ks[14], (Ld, RW_WIDTH), 0.01),
        "w_branch_a": nrm(ks[15], (Ld, RW_WIDTH, D_MODEL), RW_WIDTH),
        "w_branch_b": nrm(ks[16], (Ld, ATT_OUT, D_MODEL), ATT_OUT),
        "w_gate": nrm(ks[17], (Ld, D_MODEL, 2 * D_MODEL), D_MODEL),
        "b_gate": small(ks[18], (Ld, 2 * D_MODEL), 0.01),
        "w_out": nrm(ks[19], (Ld, D_MODEL, D_MODEL), D_MODEL),
        "g_ffn": gain(ks[20], D_MODEL),
        "w_up": nrm(ks[21], (Ld, D_MODEL, 2 * D_FF), D_MODEL),
        "conv_w": conv_w,
        "conv_b": small(ks[23], (Ld, 2 * D_FF), 0.01),
        "w_down": nrm(ks[24], (Ld, D_FF, D_MODEL), D_FF),
        "g_ple": gain(ks[25], D_MODEL),
        "w_ple_gate": nrm(ks[26], (Ld, D_MODEL, D_MODEL), D_MODEL),
        "w_ple": nrm(ks[27], (Ld, PLE_DIM, D_MODEL), PLE_DIM),
        "g_final": 1.0 + 0.1 * jax.random.normal(ks[28], (D_MODEL,), jnp.float32),
    }


def reference(x, p, g_mix, w_in, rw_mu, rw_w0, rw_w_up, rw_a0, rw_a_up, rw_g_up, rw_k_k, rw_k_a, rw_r_k,
              rw_ln_g, rw_ln_b, w_branch_a, w_branch_b, w_gate, b_gate, w_out, g_ffn, w_up, conv_w, conv_b,
              w_down, g_ple, w_ple_gate, w_ple, g_final):
    slopes = alibi_slopes(ATT_HEADS)
    for i in range(DEPTH):
        h = rms_norm(x, g_mix[i])
        proj = h @ w_in[i]
        y_a = rwkv7_time_mix(proj[..., :RW_COLS], rw_mu[i], rw_w0[i], rw_w_up[i], rw_a0[i], rw_a_up[i],
                             rw_g_up[i], rw_k_k[i], rw_k_a[i], rw_r_k[i], rw_ln_g[i], rw_ln_b[i])
        y_b = dilated_mixture_attention(proj[..., RW_COLS:], slopes)
        gate_a, gate_b = jnp.split(jax.nn.sigmoid(h @ w_gate[i] + b_gate[i]), 2, axis=-1)
        merged = gate_a * (y_a @ w_branch_a[i]) + gate_b * (y_b @ w_branch_b[i])
        x = x + merged @ w_out[i]
        x = x + conv_glu_ffn(rms_norm(x, g_ffn[i]), w_up[i], conv_w[i], conv_b[i], w_down[i])
        ple_gate = jax.nn.sigmoid(rms_norm(x, g_ple[i]) @ w_ple_gate[i])
        x = x + ple_gate * (p[i] @ w_ple[i])
    return rms_norm(x, g_final)
```

```cpp
#include <hip/hip_runtime.h>
#include <hip/hip_cooperative_groups.h>
#include <cstdio>
#include <cstdint>
namespace cg = cooperative_groups;
#ifndef MK_MULTI
#define MK_MULTI 1
#endif
namespace pg8 {
#define PG8_LAS __attribute__((address_space(3)))
typedef unsigned short bf16_t;
typedef short bf16x8 __attribute__((ext_vector_type(8)));
typedef float f32x4 __attribute__((ext_vector_type(4)));
typedef unsigned u32x4 __attribute__((ext_vector_type(4)));
constexpr int BM = 256, BK = 64, HALF = 128, HTB = HALF * BK * 2  , STAGE_BYTES = 8 * HTB, NXCD = 8, WGM = 8;

__host__ __device__ __forceinline__ int lds_byte(int r, int c) { const int st = (r >> 4) * 2 + (c >> 5), rr = r & 15, cc = c & 31, ob = rr * 64 + cc * 2; return st * 1024 + (ob ^ (((ob >> 9) & 1) << 5)); }
__host__ __device__ __forceinline__ void stage_rc(int b, int& R, int& C) { const int st = b / 1024, sb = b % 1024, swz = sb ^ (((sb >> 9) & 1) << 5); R = (st >> 1) * 16 + swz / 64; C = (st & 1) * 32 + (swz % 64) / 2; }
__host__ __device__ __forceinline__ int perm32(int rho) { const int n = rho >> 4, i = rho & 15; return 8 * (i >> 2) + 4 * n + (i & 3); }

struct Unit { int pm, pn; };
struct Gemm { const bf16_t* A; const bf16_t* Bt; int M, N, K; };
struct StaticOrder {
    int nM, nN, nwg, G, c;
    __host__ __device__ void init(int M, int N, int G_, int c_) { nM = M / BM; nN = N / BM; nwg = nM * nN; G = G_; c = c_; }
    __host__ __device__ bool next(int i, Unit& u) const {
        const long L = (long)i * G + c; if (L >= nwg) return false;
        int wgid = (int)L; { const int q = nwg / NXCD, r = nwg % NXCD, xcd = wgid % NXCD, off = wgid / NXCD; wgid = (xcd < r ? xcd * (q + 1) : r * (q + 1) + (xcd - r) * q) + off; }
        const int nig = WGM * nN, gid = wgid / nig, fm = gid * WGM, gsz = (nM - fm) < WGM ? (nM - fm) : WGM;
        u.pm = fm + ((wgid % nig) % gsz); u.pn = (wgid % nig) / gsz; return true;
    }
    __device__ __forceinline__ void a_ready(const Unit&) const {}
    __device__ __forceinline__ void done(const Unit&) const {}
};
__device__ __forceinline__ unsigned cvt_pk_bf16(float lo, float hi) { unsigned r; asm volatile("v_cvt_pk_bf16_f32 %0, %1, %2" : "=v"(r) : "v"(lo), "v"(hi)); return r; }
typedef float f32x2 __attribute__((ext_vector_type(2)));
template <class Epi, class Sched, bool ALIGN_EPI = false, bool SP2 = false>
__device__ __forceinline__ void gemm_phase(PG8_LAS unsigned char* lds, const Gemm g, const Sched& S, const Epi& E) {
    const int tid = threadIdx.x, wid = __builtin_amdgcn_readfirstlane(tid >> 6), lane = tid & 63, wr = wid >> 2, wc = wid & 3, fr = lane & 15, fq = lane >> 4;
    const int K = g.K, nt = K / BK;
    unsigned voffA[2], voffB[2];
#pragma unroll
    for (int i = 0; i < 2; ++i) { int R, C; stage_rc(tid * 16 + i * 8192, R, C); const int Rb = Epi::PERM ? ((R & ~31) + perm32(R & 31)) : R;
        voffA[i] = (unsigned)(R * K + C) * 2u; voffB[i] = (unsigned)(Rb * K + C) * 2u; }
    const size_t kstep = (size_t)(BK * 2);
    const size_t hstep = (size_t)HALF * K * 2;
    const size_t tstep = 2 * hstep;
    const unsigned ldsw = (unsigned)wid * 1024u;
    const int aoff = lds_byte(wr * 64 + fr, fq * 8), boff = lds_byte(wc * 32 + fr, fq * 8);
#define PG8_SA(b, h) (((b) * 2 + (h)) * HTB)
#define PG8_SB(b, h) ((4 + (b) * 2 + (h)) * HTB)
#define PG8_STAGE(bufoff, gbase, voff) do { _Pragma("unroll") for (int _i = 0; _i < 2; ++_i) \
        __builtin_amdgcn_global_load_lds((const unsigned*)((const char*)(gbase) + (voff)[_i]), (PG8_LAS unsigned*)(lds + (bufoff) + ldsw + _i * 8192), 16, 0, 0); } while (0)
#define PG8_LDA(dst, b, h) do { _Pragma("unroll") for (int m = 0; m < 4; ++m) _Pragma("unroll") for (int k = 0; k < 2; ++k) dst[m][k] = *(const PG8_LAS bf16x8*)(lds + PG8_SA(b, h) + aoff + m * 2048 + k * 1024); } while (0)
#define PG8_LDB(dst, b, h) do { _Pragma("unroll") for (int n = 0; n < 2; ++n) _Pragma("unroll") for (int k = 0; k < 2; ++k) dst[n][k] = *(const PG8_LAS bf16x8*)(lds + PG8_SB(b, h) + boff + n * 2048 + k * 1024); } while (0)
#define PG8_MMA(ai, bj, At, Bt) do { __builtin_amdgcn_s_setprio(1); _Pragma("unroll") for (int m = 0; m < 4; ++m) _Pragma("unroll") for (int n = 0; n < 2; ++n) _Pragma("unroll") for (int k = 0; k < 2; ++k) \
        acc[ai][bj][m][n] = __builtin_amdgcn_mfma_f32_16x16x32_bf16(Bt[n][k], At[m][k], acc[ai][bj][m][n], 0, 0, 0); __builtin_amdgcn_s_setprio(0); } while (0)
#define PG8_WAIT_V(n) asm volatile("s_waitcnt vmcnt(" #n ")" ::: "memory")
#define PG8_WAIT_L(n) asm volatile("s_waitcnt lgkmcnt(" #n ")" ::: "memory")
#define PG8_BAR __builtin_amdgcn_s_barrier()
#define PG8_SCHED __builtin_amdgcn_sched_barrier(0)
    Unit cur, nxt; int ui = 0;
    if (!S.next(0, cur)) return;
    f32x4 acc[2][2][4][2];
#pragma unroll
    for (int a = 0; a < 2; ++a)
#pragma unroll
        for (int b = 0; b < 2; ++b)
#pragma unroll
            for (int m = 0; m < 4; ++m)
#pragma unroll
                for (int n = 0; n < 2; ++n) acc[a][b][m][n] = (f32x4){0.f, 0.f, 0.f, 0.f};
    bf16x8 At[4][2], B0[2][2], B1[2][2];
    const char* cA = (const char*)g.A + (size_t)cur.pm * tstep; const char* cB = (const char*)g.Bt + (size_t)cur.pn * tstep;
    S.a_ready(cur);
    if constexpr (SP2) {
        PG8_STAGE(PG8_SB(0, 0), cB, voffB); PG8_STAGE(PG8_SB(0, 1), cB + hstep, voffB); PG8_STAGE(PG8_SA(0, 0), cA, voffA); PG8_STAGE(PG8_SA(0, 1), cA + hstep, voffA);
        if (wr == 1) PG8_BAR;
        PG8_WAIT_V(2); PG8_BAR;
        PG8_STAGE(PG8_SB(1, 0), cB + kstep, voffB); PG8_STAGE(PG8_SA(1, 0), cA + kstep, voffA); PG8_STAGE(PG8_SB(1, 1), cB + hstep + kstep, voffB);
        PG8_WAIT_V(6); PG8_BAR;
    } else {
        PG8_STAGE(PG8_SB(0, 0), cB, voffB); PG8_STAGE(PG8_SA(0, 0), cA, voffA); PG8_STAGE(PG8_SB(0, 1), cB + hstep, voffB); PG8_STAGE(PG8_SA(0, 1), cA + hstep, voffA);
        if (wr == 1) PG8_BAR;
        PG8_WAIT_V(4); PG8_BAR;
        PG8_STAGE(PG8_SB(1, 0), cB + kstep, voffB); PG8_STAGE(PG8_SA(1, 0), cA + kstep, voffA); PG8_STAGE(PG8_SB(1, 1), cB + hstep + kstep, voffB);
        PG8_WAIT_V(6); PG8_BAR;
    }
    for (;;) {
        const bool has_next = S.next(ui + 1, nxt);
        const char* nA = has_next ? (const char*)g.A + (size_t)nxt.pm * tstep : cA; const char* nB = has_next ? (const char*)g.Bt + (size_t)nxt.pn * tstep : cB;
#pragma unroll 1
        for (int t = 0; t < nt; t += 2) {
            const bool last = (t == nt - 2);
            const char* a1 = cA + (size_t)(t + 1) * kstep;
            const char* a2 = last ? nA : cA + (size_t)(t + 2) * kstep; const char* b2 = last ? nB : cB + (size_t)(t + 2) * kstep;
            const char* a3 = a2 + kstep; const char* b3 = b2 + kstep;
            if (last && has_next) S.a_ready(nxt);
            if constexpr (SP2) {
            PG8_LDB(B0, 0, 0); PG8_LDB(B1, 0, 1); PG8_SCHED; PG8_LDA(At, 0, 0); PG8_STAGE(PG8_SA(1, 1), a1 + hstep, voffA);
            PG8_WAIT_V(8); PG8_WAIT_L(0); PG8_BAR; PG8_MMA(0, 0, At, B0); PG8_MMA(0, 1, At, B1); PG8_BAR; PG8_SCHED;
            PG8_LDA(At, 0, 1); PG8_STAGE(PG8_SB(0, 0), b2, voffB); PG8_STAGE(PG8_SB(0, 1), b2 + hstep, voffB); PG8_STAGE(PG8_SA(0, 0), a2, voffA);
            PG8_WAIT_V(8); PG8_WAIT_L(0); PG8_BAR; PG8_MMA(1, 0, At, B0); PG8_MMA(1, 1, At, B1); PG8_BAR; PG8_SCHED;
            PG8_LDB(B0, 1, 0); PG8_LDB(B1, 1, 1); PG8_SCHED; PG8_LDA(At, 1, 0); PG8_STAGE(PG8_SA(0, 1), a2 + hstep, voffA);
            PG8_WAIT_V(8); PG8_WAIT_L(0); PG8_BAR; PG8_MMA(0, 0, At, B0); PG8_MMA(0, 1, At, B1); PG8_BAR; PG8_SCHED;
            PG8_LDA(At, 1, 1); PG8_STAGE(PG8_SB(1, 0), b3, voffB); PG8_STAGE(PG8_SB(1, 1), b3 + hstep, voffB); PG8_STAGE(PG8_SA(1, 0), a3, voffA);
            PG8_WAIT_V(8); PG8_WAIT_L(0); PG8_BAR; PG8_MMA(1, 0, At, B0); PG8_MMA(1, 1, At, B1); PG8_BAR; PG8_SCHED;
            } else {
            PG8_LDB(B0, 0, 0); PG8_SCHED; PG8_LDA(At, 0, 0); PG8_STAGE(PG8_SA(1, 1), a1 + hstep, voffA);
            PG8_WAIT_L(8); PG8_BAR; PG8_WAIT_L(0); PG8_MMA(0, 0, At, B0); PG8_BAR; PG8_SCHED;
            PG8_LDB(B1, 0, 1); PG8_STAGE(PG8_SB(0, 0), b2, voffB);
            PG8_BAR; PG8_WAIT_L(0); PG8_MMA(0, 1, At, B1); PG8_BAR;
            PG8_LDA(At, 0, 1); PG8_STAGE(PG8_SA(0, 0), a2, voffA);
            PG8_BAR; PG8_WAIT_L(0); PG8_MMA(1, 0, At, B0); PG8_BAR; PG8_SCHED;
            PG8_STAGE(PG8_SB(0, 1), b2 + hstep, voffB);
            PG8_WAIT_V(6); PG8_BAR; PG8_MMA(1, 1, At, B1); PG8_BAR;
            PG8_LDB(B0, 1, 0); PG8_SCHED; PG8_LDA(At, 1, 0); PG8_STAGE(PG8_SA(0, 1), a2 + hstep, voffA);
            PG8_WAIT_L(8); PG8_BAR; PG8_WAIT_L(0); PG8_MMA(0, 0, At, B0); PG8_BAR; PG8_SCHED;
            PG8_LDB(B1, 1, 1); PG8_STAGE(PG8_SB(1, 0), b3, voffB);
            PG8_BAR; PG8_WAIT_L(0); PG8_MMA(0, 1, At, B1); PG8_BAR;
            PG8_LDA(At, 1, 1); PG8_STAGE(PG8_SA(1, 0), a3, voffA);
            PG8_BAR; PG8_WAIT_L(0); PG8_MMA(1, 0, At, B0); PG8_BAR; PG8_SCHED;
            PG8_STAGE(PG8_SB(1, 1), b3 + hstep, voffB);
            PG8_WAIT_V(6); PG8_BAR; PG8_MMA(1, 1, At, B1); PG8_BAR;
            }
        }
        if constexpr (ALIGN_EPI) { if (wr == 0) PG8_BAR; }
        if constexpr (!Epi::AFTER_DRAIN) { E(acc, cur, wr, wc, fr, fq); S.done(cur); }
        if (!has_next) break;
#pragma unroll
        for (int a = 0; a < 2; ++a)
#pragma unroll
            for (int b = 0; b < 2; ++b)
#pragma unroll
                for (int m = 0; m < 4; ++m)
#pragma unroll
                    for (int n = 0; n < 2; ++n) acc[a][b][m][n] = (f32x4){0.f, 0.f, 0.f, 0.f};
        cur = nxt; cA = nA; cB = nB; ++ui;
        if constexpr (ALIGN_EPI) { if (wr == 1) PG8_BAR; }
    }
    PG8_WAIT_V(0);
    if constexpr (!ALIGN_EPI) { if (wr == 0) PG8_BAR; }
    PG8_BAR;
    if constexpr (Epi::AFTER_DRAIN) { E.fused(acc, cur, wr, wc, fr, fq, lds, wid, lane); S.done(cur); }
#undef PG8_SA
#undef PG8_SB
#undef PG8_STAGE
#undef PG8_LDA
#undef PG8_LDB
#undef PG8_MMA
#undef PG8_WAIT_V
#undef PG8_WAIT_L
#undef PG8_BAR
#undef PG8_SCHED
}
}

constexpr int NWV = 8;
constexpr int BATCH = 8, SEQ = 4096, DM = 1024, MTOK = BATCH * SEQ;
constexpr int PRW_LD = 2048, QKV_LD = 2304, N1 = 6400;
constexpr int RWC = 1824, KLORA = 384, NLORA = 1536, DFF = 3072;
constexpr float NEPS = 1e-6f;
constexpr float LOG2E = 1.4426950408889634f;
constexpr size_t HM = 512 * 1024;
constexpr size_t OFF_W1T = 0, OFF_WLORA = 25 * HM, OFF_WA = 28 * HM, OFF_WB = 30 * HM, OFF_WOUT = 31 * HM, OFF_WUP = 35 * HM, OFF_WDN = 59 * HM, OFF_WPG = 71 * HM, OFF_WPLE = 75 * HM;
constexpr size_t OFF_RS0 = 76 * HM, OFF_RSPA = 77 * HM, OFF_RSPB = 81 * HM, OFF_RK = 85 * HM, OFF_ALSE = 87 * HM, OFF_PB = 90 * HM, OFF_XB = 122 * HM, OFF_BIG = 250 * HM;
constexpr size_t OFF_PRW = OFF_BIG, OFF_QKV = 506 * HM, OFF_LW = 794 * HM, OFF_AA = 858 * HM, OFF_GG = 922 * HM;
constexpr size_t OFF_ALORA = OFF_XB, OFF_YRAW = OFF_XB, OFF_YA = OFF_LW, OFF_YB = OFF_AA, OFF_MERGED = OFF_PRW, OFF_U = OFF_BIG, OFF_HMID = 634 * HM, OFF_PL = OFF_BIG;
constexpr size_t WS_NEED = 1018 * HM;
constexpr int LDS_BYTES = 147456;
constexpr int N_PHASES = 15;
constexpr int SCAN_BLOCKS = 128;

#define LAS __attribute__((address_space(3)))
typedef unsigned short bf16_t;
typedef float f32x4 __attribute__((ext_vector_type(4)));
typedef unsigned u32x4 __attribute__((ext_vector_type(4)));
typedef unsigned u32x2 __attribute__((ext_vector_type(2)));
typedef short bf16x8 __attribute__((ext_vector_type(8)));
typedef float f32x16 __attribute__((ext_vector_type(16)));
#define LDS_WAIT() asm volatile("s_waitcnt lgkmcnt(0)" ::: "memory")

__device__ __forceinline__ float bf2f(unsigned h) { return __uint_as_float(h << 16); }
__device__ __forceinline__ float bflo(unsigned w) { return __uint_as_float(w << 16); }
__device__ __forceinline__ float bfhi(unsigned w) { return __uint_as_float(w & 0xffff0000u); }
__device__ __forceinline__ unsigned f2bf(float f) { unsigned u = __float_as_uint(f); return (u + 0x7fffu + ((u >> 16) & 1u)) >> 16; }
__device__ __forceinline__ unsigned pk2(float lo, float hi) { return f2bf(lo) | (f2bf(hi) << 16); }
__device__ __forceinline__ float sigmoidf_(float x) { return __builtin_amdgcn_rcpf(1.0f + __expf(-x)); }
__device__ __forceinline__ float wave_sum(float v) {
#pragma unroll
    for (int o = 1; o < 64; o <<= 1) v += __shfl_xor(v, o);
    return v;
}
__device__ __forceinline__ void unpack8(const u32x4 w, float (&f)[8]) { f[0] = bflo(w.x); f[1] = bfhi(w.x); f[2] = bflo(w.y); f[3] = bfhi(w.y); f[4] = bflo(w.z); f[5] = bfhi(w.z); f[6] = bflo(w.w); f[7] = bfhi(w.w); }
__device__ __forceinline__ u32x4 pack8(const float (&f)[8]) { u32x4 w; w.x = pk2(f[0], f[1]); w.y = pk2(f[2], f[3]); w.z = pk2(f[4], f[5]); w.w = pk2(f[6], f[7]); return w; }

struct Args { const float* in[29]; float* out; unsigned char* ws; int ph_lo, ph_hi; };

#define EPI_ROWS(...) _Pragma("unroll") for (int ai = 0; ai < 2; ++ai) _Pragma("unroll") for (int m = 0; m < 4; ++m) { const int row = row0 + ai * 128 + m * 16; __VA_ARGS__ asm volatile("" ::: "memory"); }
__device__ __forceinline__ u32x4 pack_acc8(const f32x4 v0, const f32x4 v1) { u32x4 w; w.x = pg8::cvt_pk_bf16(v0[0], v0[1]); w.y = pg8::cvt_pk_bf16(v0[2], v0[3]); w.z = pg8::cvt_pk_bf16(v1[0], v1[1]); w.w = pg8::cvt_pk_bf16(v1[2], v1[3]); return w; }
__device__ __forceinline__ float rstd16(const float* rsp, int row) {
    const f32x4* p = (const f32x4*)(rsp + (size_t)row * 16); const f32x4 a = p[0], b = p[1], c = p[2], d = p[3];
    const float s = (((a[0] + a[1]) + (a[2] + a[3])) + ((b[0] + b[1]) + (b[2] + b[3]))) + (((c[0] + c[1]) + (c[2] + c[3])) + ((d[0] + d[1]) + (d[2] + d[3])));
    return rsqrtf(s * (1.0f / DM) + NEPS);
}

struct EpiG1 {
    static constexpr bool PERM = true, AFTER_DRAIN = false;
    bf16_t* prw; bf16_t* qkv; bf16_t* gate; const float* rs0; const float* bg;
    __device__ __forceinline__ void operator()(const f32x4 (&acc)[2][2][4][2], const pg8::Unit& u, int wr, int wc, int fr, int fq) const {
        const int row0 = u.pm * 256 + wr * 64 + fr, ct = wc * 32 + 8 * fq;
        bf16_t* base; int ld, coff; const bool isg = u.pn >= 17;
        if (u.pn < 8) { base = prw; ld = PRW_LD; coff = u.pn * 256; } else if (u.pn < 17) { base = qkv; ld = QKV_LD; coff = (u.pn - 8) * 256; } else { base = gate; ld = 2048; coff = (u.pn - 17) * 256; }
        f32x4 bv[2][2];
#pragma unroll
        for (int bj = 0; bj < 2; ++bj)
#pragma unroll
            for (int n = 0; n < 2; ++n) bv[bj][n] = isg ? *(const f32x4*)(bg + coff + ct + bj * 128 + 4 * n) : (f32x4){0.f, 0.f, 0.f, 0.f};
        EPI_ROWS(
            const float rs = rs0[row]; bf16_t* rp = base + (size_t)row * ld + coff + ct;
            _Pragma("unroll") for (int bj = 0; bj < 2; ++bj) { f32x4 v0 = acc[ai][bj][m][0] * rs, v1 = acc[ai][bj][m][1] * rs;
                if (isg) { v0 = v0 + bv[bj][0]; v1 = v1 + bv[bj][1];
                    _Pragma("unroll") for (int e = 0; e < 4; ++e) { v0[e] = sigmoidf_(v0[e]); v1[e] = sigmoidf_(v1[e]); } }
                *(u32x4*)(rp + bj * 128) = pack_acc8(v0, v1); }
        )
    }
};
__device__ __forceinline__ float lwf(float x) { const float z = -x; const float sp = fmaxf(z, 0.f) + __logf(1.0f + __expf(-fabsf(z))); return -__expf(-sp - 0.5f); }
struct EpiSplit {
    static constexpr bool PERM = true, AFTER_DRAIN = false;
    bf16_t* O1; int ld1; int nsplit; bf16_t* O2; int ld2;
    __device__ __forceinline__ void operator()(const f32x4 (&acc)[2][2][4][2], const pg8::Unit& u, int wr, int wc, int fr, int fq) const {
        const int row0 = u.pm * 256 + wr * 64 + fr; const bool first = u.pn < nsplit;
        bf16_t* base = (first ? O1 + u.pn * 256 : O2 + (u.pn - nsplit) * 256) + wc * 32 + 8 * fq; const int ld = first ? ld1 : ld2;
        EPI_ROWS(
            bf16_t* rp = base + (size_t)row * ld;
            _Pragma("unroll") for (int bj = 0; bj < 2; ++bj) *(u32x4*)(rp + bj * 128) = pack_acc8(acc[ai][bj][m][0], acc[ai][bj][m][1]);
        )
    }
};
template <int WHICH> struct EpiBranch {
    static constexpr bool PERM = true, AFTER_DRAIN = false;
    bf16_t* merged; const bf16_t* gate;
    __device__ __forceinline__ void operator()(const f32x4 (&acc)[2][2][4][2], const pg8::Unit& u, int wr, int wc, int fr, int fq) const {
        const int row0 = u.pm * 256 + wr * 64 + fr, ct = u.pn * 256 + wc * 32 + 8 * fq;
        EPI_ROWS(
            bf16_t* rp = merged + (size_t)row * DM + ct; const bf16_t* gp = gate + (size_t)row * 2048 + WHICH * 1024 + ct;
            _Pragma("unroll") for (int bj = 0; bj < 2; ++bj) { float gv[8]; unpack8(*(const u32x4*)(gp + bj * 128), gv);
                f32x4 v0 = acc[ai][bj][m][0], v1 = acc[ai][bj][m][1];
                _Pragma("unroll") for (int e = 0; e < 4; ++e) { v0[e] *= gv[e]; v1[e] *= gv[4 + e]; }
                if (WHICH == 1) { float tv[8]; unpack8(*(const u32x4*)(rp + bj * 128), tv);
                    _Pragma("unroll") for (int e = 0; e < 4; ++e) { v0[e] += tv[e]; v1[e] += tv[4 + e]; } }
                *(u32x4*)(rp + bj * 128) = pack_acc8(v0, v1); }
        )
    }
};
template <int MODE, bool WRITE_XB> struct EpiRes {
    static constexpr bool PERM = true, AFTER_DRAIN = false;
    const float* res; float* out; bf16_t* xb; float* rsp_out; const float* rsp_in; const bf16_t* pl;
    __device__ __forceinline__ void operator()(const f32x4 (&acc)[2][2][4][2], const pg8::Unit& u, int wr, int wc, int fr, int fq) const {
        const int row0 = u.pm * 256 + wr * 64 + fr, ct = u.pn * 256 + wc * 32 + 8 * fq;
        EPI_ROWS(
            const size_t ro = (size_t)row * DM + ct; float q = 0.f; float rs = 1.f; if (MODE == 1) rs = rstd16(rsp_in, row);
            _Pragma("unroll") for (int bj = 0; bj < 2; ++bj) { f32x4 v0 = acc[ai][bj][m][0], v1 = acc[ai][bj][m][1];
                if (MODE == 1) { float pv[8]; unpack8(*(const u32x4*)(pl + ro + bj * 128), pv);
                    _Pragma("unroll") for (int e = 0; e < 4; ++e) { v0[e] = sigmoidf_(v0[e] * rs) * pv[e]; v1[e] = sigmoidf_(v1[e] * rs) * pv[4 + e]; } }
                const f32x4 r0 = *(const f32x4*)(res + ro + bj * 128), r1 = *(const f32x4*)(res + ro + bj * 128 + 4);
                v0 = v0 + r0; v1 = v1 + r1;
                *(f32x4*)(out + ro + bj * 128) = v0; *(f32x4*)(out + ro + bj * 128 + 4) = v1;
                if (WRITE_XB) *(u32x4*)(xb + ro + bj * 128) = pack_acc8(v0, v1);
                q += ((v0[0] * v0[0] + v0[1] * v0[1]) + (v0[2] * v0[2] + v0[3] * v0[3])) + ((v1[0] * v1[0] + v1[1] * v1[1]) + (v1[2] * v1[2] + v1[3] * v1[3])); }
            q += __shfl_xor(q, 16); q += __shfl_xor(q, 32);
            if (fq == 0) rsp_out[(size_t)row * 16 + u.pn * 4 + wc] = q;
        )
    }
};
struct EpiUp {
    static constexpr bool PERM = true, AFTER_DRAIN = false;
    bf16_t* U; const float* rsp; int rowbase;
    __device__ __forceinline__ void operator()(const f32x4 (&acc)[2][2][4][2], const pg8::Unit& u, int wr, int wc, int fr, int fq) const {
        const int row0 = u.pm * 256 + wr * 64 + fr, ct = u.pn * 256 + wc * 32 + 8 * fq;
        EPI_ROWS(
            const float rs = rstd16(rsp, rowbase + row); bf16_t* rp = U + (size_t)row * 6144 + ct;
            _Pragma("unroll") for (int bj = 0; bj < 2; ++bj) *(u32x4*)(rp + bj * 128) = pack_acc8(acc[ai][bj][m][0] * rs, acc[ai][bj][m][1] * rs);
        )
    }
};
struct EpiPlain {
    static constexpr bool PERM = true, AFTER_DRAIN = false;
    bf16_t* O; int ld;
    __device__ __forceinline__ void operator()(const f32x4 (&acc)[2][2][4][2], const pg8::Unit& u, int wr, int wc, int fr, int fq) const {
        const int row0 = u.pm * 256 + wr * 64 + fr, ct = u.pn * 256 + wc * 32 + 8 * fq;
        EPI_ROWS(
            bf16_t* rp = O + (size_t)row * ld + ct;
            _Pragma("unroll") for (int bj = 0; bj < 2; ++bj) *(u32x4*)(rp + bj * 128) = pack_acc8(acc[ai][bj][m][0], acc[ai][bj][m][1]);
        )
    }
};

__device__ __forceinline__ void tr_item(const float* __restrict__ W, int ldw, int k0, int n0, const float* __restrict__ g, bf16_t* WT, int ldd, int drow0, LAS float* scr, int lane) {
#pragma unroll 8
    for (int i = 0; i < 32; ++i) { const int kk = 2 * i + (lane >> 5); float v = W[(size_t)(k0 + kk) * ldw + n0 + (lane & 31)]; if (g) v *= g[k0 + kk]; scr[kk * 33 + (lane & 31)] = v; }
    LDS_WAIT();
    const int c = lane & 7;
#pragma unroll
    for (int j = 0; j < 4; ++j) { const int n = (lane >> 3) + 8 * j; const LAS float* s = scr + (8 * c) * 33 + n;
        u32x4 o; o.x = pk2(s[0 * 33], s[1 * 33]); o.y = pk2(s[2 * 33], s[3 * 33]); o.z = pk2(s[4 * 33], s[5 * 33]); o.w = pk2(s[6 * 33], s[7 * 33]);
        *(u32x4*)(WT + (size_t)(drow0 + n) * ldd + k0 + 8 * c) = o; }
    LDS_WAIT();
}
__device__ __forceinline__ void tr_matrix_item(const float* W, int K, int N, const float* g, bf16_t* WT, int r, LAS float* scr, int lane) {
    const int nblk = N / 32, kb = r / nblk, nb = r % nblk; tr_item(W, N, 64 * kb, 32 * nb, g, WT, K, 32 * nb, scr, lane);
}

__device__ __forceinline__ int crow(int r, int hi) { return (r & 3) + 8 * (r >> 2) + 4 * hi; }
__device__ __forceinline__ void attn_unit(bf16_t* QKV, float* ALSE, int unit, int lane) {
    const int g = unit >> 12, rem = unit & 4095, b = rem >> 9, hg = (rem >> 7) & 3, tile = rem & 127;
    const int d = (g == 0) ? 1 : ((g == 1) ? 4 : 16), tps = 128 / d, r = tile / tps, qt = tile % tps, i0 = 32 * qt;
    const int h = g * 4 + hg;
    const float slope = exp2f(-8.0f * (float)(h + 1) / 12.0f);
    const float c1 = 0.125f * LOG2E, c2 = slope * (float)d * LOG2E;
    const int qq = lane & 31, hi = lane >> 5;
    const size_t rowq = (size_t)b * SEQ + r + (size_t)d * (i0 + qq);
    bf16_t* qptr = QKV + rowq * QKV_LD + h * 64;
    bf16x8 qf[4];
#pragma unroll
    for (int ds = 0; ds < 4; ++ds) qf[ds] = *(const bf16x8*)(qptr + 16 * ds + 8 * hi);
    const bf16_t* Kb = QKV + ((size_t)b * SEQ + r) * QKV_LD + 768 + h * 64;
    const bf16_t* Vb = QKV + ((size_t)b * SEQ + r) * QKV_LD + 1536 + h * 64;
    float m_run = -1e30f, l_run = 0.f;
    f32x16 o0, o1;
#pragma unroll
    for (int i = 0; i < 16; ++i) { o0[i] = 0.f; o1[i] = 0.f; }
    for (int kt = 0; kt < 5; ++kt) {
        const int kb = i0 - 128 + 32 * kt;
        if (kb + 31 < 0) continue;
        const int ik = kb + qq, ikc = ik < 0 ? 0 : ik;
        const bf16_t* kp = Kb + (size_t)d * ikc * QKV_LD;
        f32x16 s;
#pragma unroll
        for (int i = 0; i < 16; ++i) s[i] = 0.f;
#pragma unroll
        for (int ds = 0; ds < 4; ++ds) { const bf16x8 kf = *(const bf16x8*)(kp + 16 * ds + 8 * hi); s = __builtin_amdgcn_mfma_f32_32x32x16_bf16(kf, qf[ds], s, 0, 0, 0); }
        float p[16]; float tmax = -1e30f;
#pragma unroll
        for (int rr = 0; rr < 16; ++rr) { const int kap = crow(rr, hi); const int st = qq + 128 - 32 * kt - kap; const bool valid = (st >= 0) && (st <= 128) && (kb + kap >= 0);
            p[rr] = valid ? (s[rr] * c1 - c2 * (float)st) : -1e30f; tmax = fmaxf(tmax, p[rr]); }
        tmax = fmaxf(tmax, __shfl_xor(tmax, 32));
        const float m_new = fmaxf(m_run, tmax), alpha = exp2f(m_run - m_new);
        float psum = 0.f;
#pragma unroll
        for (int rr = 0; rr < 16; ++rr) { p[rr] = (p[rr] > -1e29f) ? exp2f(p[rr] - m_new) : 0.f; psum += p[rr]; }
        psum += __shfl_xor(psum, 32);
        l_run = l_run * alpha + psum; m_run = m_new;
#pragma unroll
        for (int i = 0; i < 16; ++i) { o0[i] *= alpha; o1[i] *= alpha; }
#pragma unroll
        for (int j = 0; j < 2; ++j) {
            u32x4 pw; pw.x = pk2(p[8 * j + 0], p[8 * j + 1]); pw.y = pk2(p[8 * j + 2], p[8 * j + 3]); pw.z = pk2(p[8 * j + 4], p[8 * j + 5]); pw.w = pk2(p[8 * j + 6], p[8 * j + 7]);
            const bf16x8 pf = __builtin_bit_cast(bf16x8, pw);
            bf16x8 v0, v1;
#pragma unroll
            for (int e = 0; e < 8; ++e) { int key = kb + 16 * j + 8 * (e >> 2) + 4 * hi + (e & 3); key = key < 0 ? 0 : key;
                const bf16_t* vp = Vb + (size_t)d * key * QKV_LD; v0[e] = (short)vp[qq]; v1[e] = (short)vp[qq + 32]; }
            o0 = __builtin_amdgcn_mfma_f32_32x32x16_bf16(v0, pf, o0, 0, 0, 0);
            o1 = __builtin_amdgcn_mfma_f32_32x32x16_bf16(v1, pf, o1, 0, 0, 0);
        }
    }
    const float inv = 1.0f / l_run;
#pragma unroll
    for (int q4 = 0; q4 < 4; ++q4) {
        u32x2 w0, w1;
        w0.x = pk2(o0[4 * q4] * inv, o0[4 * q4 + 1] * inv); w0.y = pk2(o0[4 * q4 + 2] * inv, o0[4 * q4 + 3] * inv);
        w1.x = pk2(o1[4 * q4] * inv, o1[4 * q4 + 1] * inv); w1.y = pk2(o1[4 * q4 + 2] * inv, o1[4 * q4 + 3] * inv);
        *(u32x2*)(qptr + 8 * q4 + 4 * hi) = w0; *(u32x2*)(qptr + 32 + 8 * q4 + 4 * hi) = w1;
    }
    if (hi == 0) ALSE[((size_t)g * MTOK + rowq) * 4 + hg] = m_run + log2f(l_run);
}

__device__ __forceinline__ float dpp_add(float x, const int ctrl_sel) {
    int t;
    if (ctrl_sel == 0) t = __builtin_amdgcn_update_dpp(0, __float_as_int(x), 0xB1, 0xf, 0xf, true);
    else if (ctrl_sel == 1) t = __builtin_amdgcn_update_dpp(0, __float_as_int(x), 0x4E, 0xf, 0xf, true);
    else if (ctrl_sel == 2) t = __builtin_amdgcn_update_dpp(0, __float_as_int(x), 0x141, 0xf, 0xf, true);
    else t = __builtin_amdgcn_update_dpp(0, __float_as_int(x), 0x140, 0xf, 0xf, true);
    return x + __int_as_float(t);
}
__device__ __forceinline__ float allsum16(float x) { x = dpp_add(x, 0); x = dpp_add(x, 1); x = dpp_add(x, 2); x = dpp_add(x, 3); return x; }

constexpr int SC_NB = 32;
__device__ __forceinline__ void scan_block(const Args& a, LAS unsigned char* ldsb, int sb, int tid) {
    LAS float* OP = (LAS float*)ldsb;
    LAS float* VV = OP + SC_NB * 320;
    LAS float* YB = VV + SC_NB * 32;
    const int lane = tid & 63, w = tid >> 6;
    const int bh = sb >> 1, half = sb & 1, b = bh >> 3, h = bh & 7;
    const int rho = w * 4 + (lane >> 4), j = lane & 15;
    const bf16_t* PRW = (const bf16_t*)(a.ws + OFF_PRW); const bf16_t* LWA = (const bf16_t*)(a.ws + OFF_LW);
    float* YRAW = (float*)(a.ws + OFF_YRAW); float* RK = (float*)(a.ws + OFF_RK);
    const int hc = h * 64 + lane;
    const float kk_c = a.in[10][hc], ka_c = a.in[11][hc], rk_c = a.in[12][hc], w0_c = a.in[5][hc], a0_c = a.in[7][hc];
    const float mu_r = a.in[4][hc], mu_k = a.in[4][512 + hc], mu_v = a.in[4][1024 + hc];
    float S0 = 0.f, S1 = 0.f, S2 = 0.f, S3 = 0.f;
    const size_t mb = (size_t)b * SEQ;
    unsigned short pr[5], pk[5], pv[5], pa[4], pl[4];
#define SC_LOAD(t0) do { _Pragma("unroll") for (int i = 0; i < 5; ++i) { const int t = (t0) + 4 * w - 1 + i; \
        if (t >= 0) { const bf16_t* rp = PRW + (mb + t) * PRW_LD + hc; pr[i] = rp[0]; pk[i] = rp[512]; pv[i] = rp[1024]; } else { pr[i] = 0; pk[i] = 0; pv[i] = 0; } \
        if (i > 0) { pl[i - 1] = LWA[(mb + t) * 1024 + hc]; pa[i - 1] = LWA[(mb + t) * 1024 + 512 + hc]; } } } while (0)
    SC_LOAD(0);
    for (int t0 = 0; t0 < SEQ; t0 += SC_NB) {
#pragma unroll
        for (int i = 0; i < 4; ++i) {
            const int s = 4 * w + i;
            const float cr = bf2f(pr[i + 1]), ck = bf2f(pk[i + 1]), cv = bf2f(pv[i + 1]);
            const float r_ = cr + (bf2f(pr[i]) - cr) * mu_r, k_ = ck + (bf2f(pk[i]) - ck) * mu_k, v_ = cv + (bf2f(pv[i]) - cv) * mu_v;
            const float aa = sigmoidf_(a0_c + bf2f(pa[i])), dec = __expf(lwf(w0_c + bf2f(pl[i])));
            float kk = k_ * kk_c; const float ss = wave_sum(kk * kk); kk = kk / fmaxf(sqrtf(ss), 1e-12f);
            const float kp = k_ * (1.0f + (aa - 1.0f) * ka_c);
            const float rk = wave_sum(r_ * kp * rk_c);
            LAS float* o = OP + s * 320 + lane;
            o[0] = dec; o[64] = -kk; o[128] = kk * aa; o[192] = kp; o[256] = r_;
            if ((lane >> 5) == half) VV[s * 32 + (lane & 31)] = v_;
            if (half == 0 && lane == 0) RK[(mb + t0 + s) * 8 + h] = rk;
        }
        __syncthreads();
        if (t0 + SC_NB < SEQ) SC_LOAD(t0 + SC_NB);
#pragma unroll 4
        for (int s = 0; s < SC_NB; ++s) {
            const LAS f32x4* op = (const LAS f32x4*)(OP + s * 320) + j;
            const f32x4 wv = op[0], av = op[16], bv = op[32], kv = op[48], rv = op[64]; const float vv = VV[s * 32 + rho];
            float sa = (S0 * av[0] + S1 * av[1]) + (S2 * av[2] + S3 * av[3]);
            sa = allsum16(sa);
            S0 = S0 * wv[0] + sa * bv[0] + vv * kv[0]; S1 = S1 * wv[1] + sa * bv[1] + vv * kv[1];
            S2 = S2 * wv[2] + sa * bv[2] + vv * kv[2]; S3 = S3 * wv[3] + sa * bv[3] + vv * kv[3];
            float y = (S0 * rv[0] + S1 * rv[1]) + (S2 * rv[2] + S3 * rv[3]);
            y = allsum16(y);
            if (j == 0) YB[s * 32 + rho] = y;
        }
        __syncthreads();
#pragma unroll
        for (int e = tid; e < SC_NB * 32; e += 512) { const int s = e >> 5, rr = e & 31; YRAW[(mb + t0 + s) * 512 + h * 64 + 32 * half + rr] = YB[e]; }
    }
#undef SC_LOAD
}

__device__ __forceinline__ float gelu_tanh(float x) { const float u = 0.7978845608028654f * (x + 0.044715f * x * x * x); const float t = 1.0f - 2.0f * __builtin_amdgcn_rcpf(1.0f + __expf(2.0f * u)); return 0.5f * x * (1.0f + t); }

__global__ void __launch_bounds__(NWV * 64, 2) mk_fwd(Args a) {
    extern __shared__ __attribute__((aligned(16))) unsigned char lds_raw[];
    LAS unsigned char* lds = (LAS unsigned char*)lds_raw;
    const int tid = threadIdx.x, lane = tid & 63, wave = __builtin_amdgcn_readfirstlane(tid >> 6);
    const int G = gridDim.x, bx = blockIdx.x;
    const int gw = bx * NWV + wave, NGW = G * NWV;
    const int gt = bx * (NWV * 64) + tid, NGT = G * NWV * 64;
    unsigned char* ws = a.ws;
    bf16_t* W1T = (bf16_t*)(ws + OFF_W1T); bf16_t* WLORA = (bf16_t*)(ws + OFF_WLORA); bf16_t* WA = (bf16_t*)(ws + OFF_WA); bf16_t* WB = (bf16_t*)(ws + OFF_WB);
    bf16_t* WOUT = (bf16_t*)(ws + OFF_WOUT); bf16_t* WUP = (bf16_t*)(ws + OFF_WUP); bf16_t* WDN = (bf16_t*)(ws + OFF_WDN); bf16_t* WPG = (bf16_t*)(ws + OFF_WPG); bf16_t* WPLE = (bf16_t*)(ws + OFF_WPLE);
    float* RS0 = (float*)(ws + OFF_RS0); float* RSPA = (float*)(ws + OFF_RSPA); float* RSPB = (float*)(ws + OFF_RSPB); float* RK = (float*)(ws + OFF_RK); float* ALSE = (float*)(ws + OFF_ALSE);
    bf16_t* PB = (bf16_t*)(ws + OFF_PB); bf16_t* XB = (bf16_t*)(ws + OFF_XB); bf16_t* PRW = (bf16_t*)(ws + OFF_PRW); bf16_t* QKV = (bf16_t*)(ws + OFF_QKV);
    bf16_t* LW = (bf16_t*)(ws + OFF_LW); bf16_t* AA = (bf16_t*)(ws + OFF_AA); bf16_t* GG = (bf16_t*)(ws + OFF_GG); bf16_t* ALORA = (bf16_t*)(ws + OFF_ALORA);
    float* YRAW = (float*)(ws + OFF_YRAW); bf16_t* YA = (bf16_t*)(ws + OFF_YA); bf16_t* YB = (bf16_t*)(ws + OFF_YB); bf16_t* MERGED = (bf16_t*)(ws + OFF_MERGED);
    bf16_t* UU = (bf16_t*)(ws + OFF_U); bf16_t* HMID = (bf16_t*)(ws + OFF_HMID); bf16_t* PL = (bf16_t*)(ws + OFF_PL);
    bf16_t* GATE = (bf16_t*)a.out;
    const int lo = a.ph_lo, hi = a.ph_hi;
#ifndef ONLY_PHASE
#define ONLY_PHASE -1
#endif
#define IN(k) ((ONLY_PHASE < 0 || ONLY_PHASE == (k) || (ONLY_PHASE == 8 && (k) == 10) || (ONLY_PHASE == 9 && (k) == 11)) && lo <= (k) && (k) < hi)
#define SEAM(k) do { if (IN(k) && IN((k) + 1)) { __threadfence(); cg::this_grid().sync(); } } while (0)

    if (IN(0)) {
        LAS float* scr = (LAS float*)(lds + wave * 16384);
        constexpr int I_WIN = 16 * 129, I_WG = 16 * 64, I_WA = 8 * 32, I_WB = 4 * 32, I_WO = 16 * 32, I_WUP = 16 * 192, I_WD = 48 * 32, I_WPG = 16 * 32, I_WPLE = 4 * 32;
        constexpr int NIT = I_WIN + I_WG + I_WA + I_WB + I_WO + I_WUP + I_WD + I_WPG + I_WPLE;
        for (int it = gw; it < NIT; it += NGW) {
            int r = it;
            if (r < I_WIN) { const int kb = r / 129, nb = r % 129, n0 = 32 * nb; tr_item(a.in[3], 4128, 64 * kb, n0, a.in[2], W1T, DM, n0 < RWC ? n0 : n0 + 224, scr, lane); continue; } r -= I_WIN;
            if (r < I_WG) { const int kb = r / 64, nb = r % 64; tr_item(a.in[17], 2048, 64 * kb, 32 * nb, a.in[2], W1T, DM, 4352 + 32 * nb, scr, lane); continue; } r -= I_WG;
            if (r < I_WA) { tr_matrix_item(a.in[15], 512, DM, nullptr, WA, r, scr, lane); continue; } r -= I_WA;
            if (r < I_WB) { tr_matrix_item(a.in[16], 256, DM, nullptr, WB, r, scr, lane); continue; } r -= I_WB;
            if (r < I_WO) { tr_matrix_item(a.in[19], DM, DM, nullptr, WOUT, r, scr, lane); continue; } r -= I_WO;
            if (r < I_WUP) { tr_matrix_item(a.in[21], DM, 6144, a.in[20], WUP, r, scr, lane); continue; } r -= I_WUP;
            if (r < I_WD) { tr_matrix_item(a.in[24], DFF, DM, nullptr, WDN, r, scr, lane); continue; } r -= I_WD;
            if (r < I_WPG) { tr_matrix_item(a.in[26], DM, DM, a.in[25], WPG, r, scr, lane); continue; } r -= I_WPG;
            tr_matrix_item(a.in[27], 256, DM, nullptr, WPLE, r, scr, lane);
        }
        for (int e = gt; e < NLORA * KLORA; e += NGT) { const int n = e / KLORA, k = e % KLORA; float v = 0.f;
            if (n < 512) { if (k < 64) v = a.in[6][k * 512 + n]; } else if (n < 1024) { if (k >= 64 && k < 128) v = a.in[8][(k - 64) * 512 + (n - 512)]; } else { if (k >= 128 && k < 288) v = a.in[9][(k - 128) * 512 + (n - 1024)]; }
            WLORA[e] = (bf16_t)f2bf(v); }
        for (int e = gt; e < 224 * DM / 8; e += NGT) *(u32x4*)(W1T + (size_t)RWC * DM + (size_t)e * 8) = (u32x4){0u, 0u, 0u, 0u};
        for (int m = gw; m < MTOK; m += NGW) {
            const f32x4* xr = (const f32x4*)(a.in[0] + (size_t)m * DM) + lane; f32x4 v[4]; float s = 0.f;
#pragma unroll
            for (int jj = 0; jj < 4; ++jj) { v[jj] = xr[64 * jj]; s += (v[jj][0] * v[jj][0] + v[jj][1] * v[jj][1]) + (v[jj][2] * v[jj][2] + v[jj][3] * v[jj][3]); }
            s = wave_sum(s); if (lane == 0) RS0[m] = rsqrtf(s * (1.0f / DM) + NEPS);
            u32x2* o8 = (u32x2*)(XB + (size_t)m * DM) + lane;
#pragma unroll
            for (int jj = 0; jj < 4; ++jj) { u32x2 o; o.x = pk2(v[jj][0], v[jj][1]); o.y = pk2(v[jj][2], v[jj][3]); o8[64 * jj] = o; }
        }
        for (int c = gt; c < MTOK * 256 / 8; c += NGT) { const f32x4* pp = (const f32x4*)(a.in[1] + (size_t)c * 8); const f32x4 p0 = pp[0], p1 = pp[1];
            u32x4 o; o.x = pk2(p0[0], p0[1]); o.y = pk2(p0[2], p0[3]); o.z = pk2(p1[0], p1[1]); o.w = pk2(p1[2], p1[3]); *(u32x4*)(PB + (size_t)c * 8) = o; }
        __syncthreads();
    }
    SEAM(0);
    if (IN(1)) {
        pg8::Gemm g{XB, W1T, MTOK, N1, DM}; pg8::StaticOrder S; S.init(MTOK, N1, G, bx);
        EpiG1 E{PRW, QKV, GATE, RS0, a.in[18]};
        pg8::gemm_phase<EpiG1, pg8::StaticOrder, true, true>(lds, g, S, E);
    }
    SEAM(1);
    if (IN(2)) {
        for (int m = gw; m < MTOK; m += NGW) {
            const int t = m & (SEQ - 1);
            if (lane < 36) {
                const int c = 1536 + 8 * lane; float cur[8], prv[8];
                unpack8(*(const u32x4*)(PRW + (size_t)m * PRW_LD + c), cur);
                if (t > 0) unpack8(*(const u32x4*)(PRW + (size_t)(m - 1) * PRW_LD + c), prv); else { _Pragma("unroll") for (int e = 0; e < 8; ++e) prv[e] = 0.f; }
                const f32x4 mu0 = *(const f32x4*)(a.in[4] + c), mu1 = *(const f32x4*)(a.in[4] + c + 4); float o[8];
#pragma unroll
                for (int e = 0; e < 8; ++e) { const float muv = e < 4 ? mu0[e] : mu1[e - 4]; const float pm = cur[e] + (prv[e] - cur[e]) * muv;
                    o[e] = (c < 1600) ? (1.0f - 2.0f * __builtin_amdgcn_rcpf(1.0f + __expf(2.0f * pm))) : ((c < 1664) ? pm : sigmoidf_(pm)); }
                *(u32x4*)(ALORA + (size_t)m * KLORA + 8 * lane) = pack8(o);
            } else if (lane < 48) *(u32x4*)(ALORA + (size_t)m * KLORA + 8 * lane) = (u32x4){0u, 0u, 0u, 0u};
        }
    }
    SEAM(2);
    if (IN(3)) {
        pg8::Gemm g{ALORA, WLORA, MTOK, NLORA, KLORA}; pg8::StaticOrder S; S.init(MTOK, NLORA, G, bx);
        EpiSplit E{LW, 1024, 4, GG, 512};
        pg8::gemm_phase<EpiSplit, pg8::StaticOrder, true, true>(lds, g, S, E);
    }
    SEAM(3);
    if (IN(4)) {
        if (bx < SCAN_BLOCKS) scan_block(a, lds, bx, tid);
        else { const int nw = (G - SCAN_BLOCKS) * NWV; for (int u = (bx - SCAN_BLOCKS) * NWV + wave; u < 3 * 4096; u += nw) attn_unit(QKV, ALSE, u, lane); }
        __syncthreads();
    }
    SEAM(4);
    if (IN(5)) {
        for (int m = gw; m < MTOK; m += NGW) {
            const int t = m & (SEQ - 1);
#pragma unroll 2
            for (int h = 0; h < 8; ++h) { const int hc = h * 64 + lane;
                const float y = YRAW[(size_t)m * 512 + hc];
                const float mean = wave_sum(y) * (1.0f / 64.0f), dl = y - mean, var = wave_sum(dl * dl) * (1.0f / 64.0f);
                const float yn = dl * rsqrtf(var + 64e-5f) * a.in[13][hc] + a.in[14][hc];
                const float cv = bf2f(PRW[(size_t)m * PRW_LD + 1024 + hc]), pvv = t > 0 ? bf2f(PRW[(size_t)(m - 1) * PRW_LD + 1024 + hc]) : 0.f;
                const float vv = cv + (pvv - cv) * a.in[4][1024 + hc];
                const float bonus = RK[(size_t)m * 8 + h] * vv;
                YA[(size_t)m * 512 + hc] = (bf16_t)f2bf((yn + bonus) * bf2f(GG[(size_t)m * 512 + hc])); }
#pragma unroll
            for (int hg = 0; hg < 4; ++hg) {
                const float l0 = ALSE[((size_t)0 * MTOK + m) * 4 + hg], l1 = ALSE[((size_t)1 * MTOK + m) * 4 + hg], l2 = ALSE[((size_t)2 * MTOK + m) * 4 + hg];
                const float mx = fmaxf(l0, fmaxf(l1, l2)), w0 = exp2f(l0 - mx), w1 = exp2f(l1 - mx), w2 = exp2f(l2 - mx), inv = 1.0f / (w0 + w1 + w2);
                const bf16_t* qp = QKV + (size_t)m * QKV_LD + hg * 64 + lane;
                const float o = w0 * bf2f(qp[0]) + w1 * bf2f(qp[256]) + w2 * bf2f(qp[512]);
                YB[(size_t)m * 256 + hg * 64 + lane] = (bf16_t)f2bf(o * inv); }
        }
    }
    SEAM(5);
    if (IN(6)) {
        { pg8::Gemm g{YA, WA, MTOK, DM, 512}; pg8::StaticOrder S; S.init(MTOK, DM, G, bx); EpiBranch<0> E{MERGED, GATE};
          pg8::gemm_phase<EpiBranch<0>, pg8::StaticOrder, true, true>(lds, g, S, E); }
        __syncthreads();
        { pg8::Gemm g{YB, WB, MTOK, DM, 256}; pg8::StaticOrder S; S.init(MTOK, DM, G, bx); EpiBranch<1> E{MERGED, GATE};
          pg8::gemm_phase<EpiBranch<1>, pg8::StaticOrder, true, true>(lds, g, S, E); }
    }
    SEAM(6);
    if (IN(7)) {
        pg8::Gemm g{MERGED, WOUT, MTOK, DM, DM}; pg8::StaticOrder S; S.init(MTOK, DM, G, bx);
        EpiRes<0, true> E{a.in[0], a.out, XB, RSPA, nullptr, nullptr};
        pg8::gemm_phase<EpiRes<0, true>, pg8::StaticOrder, true, true>(lds, g, S, E);
    }
    SEAM(7);
#pragma unroll 1
    for (int hf = 0; hf < 2; ++hf) {
        if (IN(8 + 2 * hf)) {
            pg8::Gemm g{XB + (size_t)hf * 16384 * DM, WUP, 16384, 6144, DM}; pg8::StaticOrder S; S.init(16384, 6144, G, bx);
            EpiUp E{UU, RSPA, hf * 16384};
            pg8::gemm_phase<EpiUp, pg8::StaticOrder, true, true>(lds, g, S, E);
        }
        SEAM(8 + 2 * hf);
        if (IN(9 + 2 * hf)) {
            for (int it = gw; it < 6 * 1024; it += NGW) {
                const int cgp = it % 6, strip = it / 6, jc = cgp * 512 + lane * 8, r0 = strip * 16;
                float cwg[3][8], cwv[3][8], cbg[8], cbv[8];
#pragma unroll
                for (int i = 0; i < 3; ++i) { const f32x4 x0 = *(const f32x4*)(a.in[22] + i * 6144 + jc), x1 = *(const f32x4*)(a.in[22] + i * 6144 + jc + 4), y0 = *(const f32x4*)(a.in[22] + i * 6144 + 3072 + jc), y1 = *(const f32x4*)(a.in[22] + i * 6144 + 3072 + jc + 4);
                    _Pragma("unroll") for (int e = 0; e < 4; ++e) { cwg[i][e] = x0[e]; cwg[i][4 + e] = x1[e]; cwv[i][e] = y0[e]; cwv[i][4 + e] = y1[e]; } }
                { const f32x4 x0 = *(const f32x4*)(a.in[23] + jc), x1 = *(const f32x4*)(a.in[23] + jc + 4), y0 = *(const f32x4*)(a.in[23] + 3072 + jc), y1 = *(const f32x4*)(a.in[23] + 3072 + jc + 4);
                    _Pragma("unroll") for (int e = 0; e < 4; ++e) { cbg[e] = x0[e]; cbg[4 + e] = x1[e]; cbv[e] = y0[e]; cbv[4 + e] = y1[e]; } }
                float g1[8], g2[8], v1[8], v2[8];
                const int tstart = r0 & (SEQ - 1);
                if (tstart >= 2) { unpack8(*(const u32x4*)(UU + (size_t)(r0 - 1) * 6144 + jc), g1); unpack8(*(const u32x4*)(UU + (size_t)(r0 - 2) * 6144 + jc), g2);
                    unpack8(*(const u32x4*)(UU + (size_t)(r0 - 1) * 6144 + 3072 + jc), v1); unpack8(*(const u32x4*)(UU + (size_t)(r0 - 2) * 6144 + 3072 + jc), v2); }
                else { _Pragma("unroll") for (int e = 0; e < 8; ++e) { g1[e] = 0.f; g2[e] = 0.f; v1[e] = 0.f; v2[e] = 0.f; } }
#pragma unroll 4
                for (int rr = 0; rr < 16; ++rr) { const int r = r0 + rr; float g0[8], v0[8], o[8];
                    unpack8(*(const u32x4*)(UU + (size_t)r * 6144 + jc), g0); unpack8(*(const u32x4*)(UU + (size_t)r * 6144 + 3072 + jc), v0);
                    _Pragma("unroll") for (int e = 0; e < 8; ++e) { const float ug = cbg[e] + cwg[0][e] * g0[e] + cwg[1][e] * g1[e] + cwg[2][e] * g2[e]; const float uv = cbv[e] + cwv[0][e] * v0[e] + cwv[1][e] * v1[e] + cwv[2][e] * v2[e];
                        o[e] = gelu_tanh(ug) * uv; g2[e] = g1[e]; g1[e] = g0[e]; v2[e] = v1[e]; v1[e] = v0[e]; }
                    *(u32x4*)(HMID + ((size_t)hf * 16384 + r) * DFF + jc) = pack8(o); }
            }
        }
        SEAM(9 + 2 * hf);
    }
    if (IN(12)) {
        { pg8::Gemm g{HMID, WDN, MTOK, DM, DFF}; pg8::StaticOrder S; S.init(MTOK, DM, G, bx);
          EpiRes<0, true> E{a.out, a.out, XB, RSPB, nullptr, nullptr};
          pg8::gemm_phase<EpiRes<0, true>, pg8::StaticOrder, true, true>(lds, g, S, E); }
        __syncthreads();
        { pg8::Gemm g{PB, WPLE, MTOK, DM, 256}; pg8::StaticOrder S; S.init(MTOK, DM, G, bx); EpiPlain E{PL, DM};
          pg8::gemm_phase<EpiPlain, pg8::StaticOrder, true, true>(lds, g, S, E); }
    }
    SEAM(12);
    if (IN(13)) {
        pg8::Gemm g{XB, WPG, MTOK, DM, DM}; pg8::StaticOrder S; S.init(MTOK, DM, G, bx);
        EpiRes<1, false> E{a.out, a.out, nullptr, RSPA, RSPB, PL};
        pg8::gemm_phase<EpiRes<1, false>, pg8::StaticOrder, true, true>(lds, g, S, E);
    }
    SEAM(13);
    if (IN(14)) {
        for (int m = gw; m < MTOK; m += NGW) {
            const float rs = rstd16(RSPA, m);
            f32x4* xr = (f32x4*)(a.out + (size_t)m * DM) + lane; const f32x4* gr = (const f32x4*)a.in[28] + lane;
#pragma unroll
            for (int jj = 0; jj < 4; ++jj) { const f32x4 v = xr[64 * jj], gf = gr[64 * jj]; xr[64 * jj] = v * rs * gf; }
        }
    }
#undef IN
#undef SEAM
}

extern "C" void kernel_launch(void* const* d_in, const int* in_sizes, int n_in, void* d_out, int out_size, void* d_ws, size_t ws_size, hipStream_t stream) {
    static int grid = 0;
    if (grid == 0) {
        if (n_in != 29 || out_size != MTOK * DM || ws_size < WS_NEED) { fprintf(stderr, "kernel_launch: unexpected shapes (n_in %d out %d ws %zu need %zu)\n", n_in, out_size, ws_size, (size_t)WS_NEED); grid = -1; return; }
        int dev = 0, cus = 0, per_cu = 0;
        hipGetDevice(&dev); hipDeviceGetAttribute(&cus, hipDeviceAttributeMultiprocessorCount, dev);
        if (hipFuncSetAttribute((const void*)mk_fwd, hipFuncAttributeMaxDynamicSharedMemorySize, LDS_BYTES) != hipSuccess) { fprintf(stderr, "kernel_launch: hipFuncSetAttribute failed\n"); grid = -1; return; }
        if (hipOccupancyMaxActiveBlocksPerMultiprocessor(&per_cu, (const void*)mk_fwd, NWV * 64, LDS_BYTES) != hipSuccess || per_cu < 1) { fprintf(stderr, "kernel_launch: occupancy query says %d\n", per_cu); per_cu = 1; }
        (void)hipGetLastError();
        grid = cus * per_cu; if (grid > 256) grid = 256;
        if (grid < 256) fprintf(stderr, "kernel_launch: grid %d < 256\n", grid);
    }
    if (grid < 0) return;
    Args a{};
    for (int i = 0; i < 29; ++i) a.in[i] = (const float*)d_in[i];
    a.out = (float*)d_out; a.ws = (unsigned char*)d_ws;
#if MK_MULTI
    for (int ph = 0; ph < N_PHASES; ++ph) { a.ph_lo = ph; a.ph_hi = ph + 1; hipLaunchKernelGGL(mk_fwd, dim3(grid), dim3(NWV * 64), LDS_BYTES, stream, a); }
#else
    a.ph_lo = 0; a.ph_hi = N_PHASES;
    void* args[] = {&a};
    hipError_t e = hipLaunchCooperativeKernel((const void*)mk_fwd, dim3(grid), dim3(NWV * 64), args, LDS_BYTES, stream);
    if (e != hipSuccess) fprintf(stderr, "kernel_launch: cooperative launch failed: %s (grid %d)\n", hipGetErrorString(e), grid);
#endif
}
```

```cpp
#include <hip/hip_runtime.h>
#include <hip/hip_cooperative_groups.h>
#include <cstdio>
#include <cstdint>
namespace cg = cooperative_groups;
#ifndef MK_MULTI
#define MK_MULTI 0
#endif
namespace pg8 {
#define PG8_LAS __attribute__((address_space(3)))
typedef unsigned short bf16_t;
typedef short bf16x8 __attribute__((ext_vector_type(8)));
typedef float f32x4 __attribute__((ext_vector_type(4)));
typedef unsigned u32x4 __attribute__((ext_vector_type(4)));
constexpr int BM = 256, BK = 64, HALF = 128, HTB = HALF * BK * 2  , STAGE_BYTES = 8 * HTB, NXCD = 8, WGM = 4;

__host__ __device__ __forceinline__ int lds_byte(int r, int c) { const int st = (r >> 4) * 2 + (c >> 5), rr = r & 15, cc = c & 31, ob = rr * 64 + cc * 2; return st * 1024 + (ob ^ (((ob >> 9) & 1) << 5)); }
__host__ __device__ __forceinline__ void stage_rc(int b, int& R, int& C) { const int st = b / 1024, sb = b % 1024, swz = sb ^ (((sb >> 9) & 1) << 5); R = (st >> 1) * 16 + swz / 64; C = (st & 1) * 32 + (swz % 64) / 2; }
__host__ __device__ __forceinline__ int perm32(int rho) { const int n = rho >> 4, i = rho & 15; return 8 * (i >> 2) + 4 * n + (i & 3); }

struct Unit { int pm, pn; };
struct Gemm { const bf16_t* A; const bf16_t* Bt; int M, N, K; };
struct StaticOrder {
    int nM, nN, nwg, G, c;
    __host__ __device__ void init(int M, int N, int G_, int c_) { nM = M / BM; nN = N / BM; nwg = nM * nN; G = G_; c = c_; }
    __host__ __device__ bool next(int i, Unit& u) const {
        const long L = (long)i * G + c; if (L >= nwg) return false;
        int wgid = (int)L; { const int q = nwg / NXCD, r = nwg % NXCD, xcd = wgid % NXCD, off = wgid / NXCD; wgid = (xcd < r ? xcd * (q + 1) : r * (q + 1) + (xcd - r) * q) + off; }
        const int nig = WGM * nN, gid = wgid / nig, fm = gid * WGM, gsz = (nM - fm) < WGM ? (nM - fm) : WGM;
        u.pm = fm + ((wgid % nig) % gsz); u.pn = (wgid % nig) / gsz; return true;
    }
    __device__ __forceinline__ long arow(int pm) const { return (long)pm * BM; }
    __device__ __forceinline__ void a_ready(const Unit&) const {}
    __device__ __forceinline__ void done(const Unit&) const {}
};
__device__ __forceinline__ unsigned cvt_pk_bf16(float lo, float hi) { unsigned r; asm volatile("v_cvt_pk_bf16_f32 %0, %1, %2" : "=v"(r) : "v"(lo), "v"(hi)); return r; }
typedef float f32x2 __attribute__((ext_vector_type(2)));
template <class Epi, class Sched, bool ALIGN_EPI = false, bool SP2 = false>
__device__ __forceinline__ void gemm_phase(PG8_LAS unsigned char* lds, const Gemm g, const Sched& S, const Epi& E) {
    const int tid = threadIdx.x, wid = __builtin_amdgcn_readfirstlane(tid >> 6), lane = tid & 63, wr = wid >> 2, wc = wid & 3, fr = lane & 15, fq = lane >> 4;
    const int K = g.K, nt = K / BK;
    unsigned voffA[2], voffB[2];
#pragma unroll
    for (int i = 0; i < 2; ++i) { int R, C; stage_rc(tid * 16 + i * 8192, R, C); const int Rb = Epi::PERM ? ((R & ~31) + perm32(R & 31)) : R;
        voffA[i] = (unsigned)(R * K + C) * 2u; voffB[i] = (unsigned)(Rb * K + C) * 2u; }
    const size_t kstep = (size_t)(BK * 2);
    const size_t hstep = (size_t)HALF * K * 2;
    const size_t tstep = 2 * hstep;
    const unsigned ldsw = (unsigned)wid * 1024u;
    const int aoff = lds_byte(wr * 64 + fr, fq * 8), boff = lds_byte(wc * 32 + fr, fq * 8);
#define PG8_SA(b, h) (((b) * 2 + (h)) * HTB)
#define PG8_SB(b, h) ((4 + (b) * 2 + (h)) * HTB)
#define PG8_STAGE(bufoff, gbase, voff) do { _Pragma("unroll") for (int _i = 0; _i < 2; ++_i) \
        __builtin_amdgcn_global_load_lds((const unsigned*)((const char*)(gbase) + (voff)[_i]), (PG8_LAS unsigned*)(lds + (bufoff) + ldsw + _i * 8192), 16, 0, 0); } while (0)
#define PG8_LDA(dst, b, h) do { _Pragma("unroll") for (int m = 0; m < 4; ++m) _Pragma("unroll") for (int k = 0; k < 2; ++k) dst[m][k] = *(const PG8_LAS bf16x8*)(lds + PG8_SA(b, h) + aoff + m * 2048 + k * 1024); } while (0)
#define PG8_LDB(dst, b, h) do { _Pragma("unroll") for (int n = 0; n < 2; ++n) _Pragma("unroll") for (int k = 0; k < 2; ++k) dst[n][k] = *(const PG8_LAS bf16x8*)(lds + PG8_SB(b, h) + boff + n * 2048 + k * 1024); } while (0)
#define PG8_MMA(ai, bj, At, Bt) do { __builtin_amdgcn_s_setprio(1); _Pragma("unroll") for (int m = 0; m < 4; ++m) _Pragma("unroll") for (int n = 0; n < 2; ++n) _Pragma("unroll") for (int k = 0; k < 2; ++k) \
        acc[ai][bj][m][n] = __builtin_amdgcn_mfma_f32_16x16x32_bf16(Bt[n][k], At[m][k], acc[ai][bj][m][n], 0, 0, 0); __builtin_amdgcn_s_setprio(0); } while (0)
#define PG8_WAIT_V(n) asm volatile("s_waitcnt vmcnt(" #n ")" ::: "memory")
#define PG8_WAIT_L(n) asm volatile("s_waitcnt lgkmcnt(" #n ")" ::: "memory")
#define PG8_BAR __builtin_amdgcn_s_barrier()
#define PG8_SCHED __builtin_amdgcn_sched_barrier(0)
    Unit cur, nxt; int ui = 0;
    if (!S.next(0, cur)) return;
    f32x4 acc[2][2][4][2];
#pragma unroll
    for (int a = 0; a < 2; ++a)
#pragma unroll
        for (int b = 0; b < 2; ++b)
#pragma unroll
            for (int m = 0; m < 4; ++m)
#pragma unroll
                for (int n = 0; n < 2; ++n) acc[a][b][m][n] = (f32x4){0.f, 0.f, 0.f, 0.f};
    bf16x8 At[4][2], B0[2][2], B1[2][2];
    const char* cA = (const char*)g.A + (long)S.arow(cur.pm) * (long)(K * 2); const char* cB = (const char*)g.Bt + (size_t)cur.pn * tstep;
    S.a_ready(cur);
    if constexpr (SP2) {
        PG8_STAGE(PG8_SB(0, 0), cB, voffB); PG8_STAGE(PG8_SB(0, 1), cB + hstep, voffB); PG8_STAGE(PG8_SA(0, 0), cA, voffA); PG8_STAGE(PG8_SA(0, 1), cA + hstep, voffA);
        if (wr == 1) PG8_BAR;
        PG8_WAIT_V(2); PG8_BAR;
        PG8_STAGE(PG8_SB(1, 0), cB + kstep, voffB); PG8_STAGE(PG8_SA(1, 0), cA + kstep, voffA); PG8_STAGE(PG8_SB(1, 1), cB + hstep + kstep, voffB);
        PG8_WAIT_V(6); PG8_BAR;
    } else {
        PG8_STAGE(PG8_SB(0, 0), cB, voffB); PG8_STAGE(PG8_SA(0, 0), cA, voffA); PG8_STAGE(PG8_SB(0, 1), cB + hstep, voffB); PG8_STAGE(PG8_SA(0, 1), cA + hstep, voffA);
        if (wr == 1) PG8_BAR;
        PG8_WAIT_V(4); PG8_BAR;
        PG8_STAGE(PG8_SB(1, 0), cB + kstep, voffB); PG8_STAGE(PG8_SA(1, 0), cA + kstep, voffA); PG8_STAGE(PG8_SB(1, 1), cB + hstep + kstep, voffB);
        PG8_WAIT_V(6); PG8_BAR;
    }
    for (;;) {
        const bool has_next = S.next(ui + 1, nxt);
        const char* nA = has_next ? (const char*)g.A + (long)S.arow(nxt.pm) * (long)(K * 2) : cA; const char* nB = has_next ? (const char*)g.Bt + (size_t)nxt.pn * tstep : cB;
#pragma unroll 1
        for (int t = 0; t < nt; t += 2) {
            const bool last = (t == nt - 2);
            const char* a1 = cA + (size_t)(t + 1) * kstep;
            const char* a2 = last ? nA : cA + (size_t)(t + 2) * kstep; const char* b2 = last ? nB : cB + (size_t)(t + 2) * kstep;
            const char* a3 = a2 + kstep; const char* b3 = b2 + kstep;
            if (last && has_next) S.a_ready(nxt);
            if constexpr (SP2) {
            PG8_LDB(B0, 0, 0); PG8_LDB(B1, 0, 1); PG8_SCHED; PG8_LDA(At, 0, 0); PG8_STAGE(PG8_SA(1, 1), a1 + hstep, voffA);
            PG8_WAIT_V(8); PG8_WAIT_L(0); PG8_BAR; PG8_MMA(0, 0, At, B0); PG8_MMA(0, 1, At, B1); PG8_BAR; PG8_SCHED;
            PG8_LDA(At, 0, 1); PG8_STAGE(PG8_SB(0, 0), b2, voffB); PG8_STAGE(PG8_SB(0, 1), b2 + hstep, voffB); PG8_STAGE(PG8_SA(0, 0), a2, voffA);
            PG8_WAIT_V(8); PG8_WAIT_L(0); PG8_BAR; PG8_MMA(1, 0, At, B0); PG8_MMA(1, 1, At, B1); PG8_BAR; PG8_SCHED;
            PG8_LDB(B0, 1, 0); PG8_LDB(B1, 1, 1); PG8_SCHED; PG8_LDA(At, 1, 0); PG8_STAGE(PG8_SA(0, 1), a2 + hstep, voffA);
            PG8_WAIT_V(8); PG8_WAIT_L(0); PG8_BAR; PG8_MMA(0, 0, At, B0); PG8_MMA(0, 1, At, B1); PG8_BAR; PG8_SCHED;
            PG8_LDA(At, 1, 1); PG8_STAGE(PG8_SB(1, 0), b3, voffB); PG8_STAGE(PG8_SB(1, 1), b3 + hstep, voffB); PG8_STAGE(PG8_SA(1, 0), a3, voffA);
            PG8_WAIT_V(8); PG8_WAIT_L(0); PG8_BAR; PG8_MMA(1, 0, At, B0); PG8_MMA(1, 1, At, B1); PG8_BAR; PG8_SCHED;
            } else {
            PG8_LDB(B0, 0, 0); PG8_SCHED; PG8_LDA(At, 0, 0); PG8_STAGE(PG8_SA(1, 1), a1 + hstep, voffA);
            PG8_WAIT_L(8); PG8_BAR; PG8_WAIT_L(0); PG8_MMA(0, 0, At, B0); PG8_BAR; PG8_SCHED;
            PG8_LDB(B1, 0, 1); PG8_STAGE(PG8_SB(0, 0), b2, voffB);
            PG8_BAR; PG8_WAIT_L(0); PG8_MMA(0, 1, At, B1); PG8_BAR;
            PG8_LDA(At, 0, 1); PG8_STAGE(PG8_SA(0, 0), a2, voffA);
            PG8_BAR; PG8_WAIT_L(0); PG8_MMA(1, 0, At, B0); PG8_BAR; PG8_SCHED;
            PG8_STAGE(PG8_SB(0, 1), b2 + hstep, voffB);
            PG8_WAIT_V(6); PG8_BAR; PG8_MMA(1, 1, At, B1); PG8_BAR;
            PG8_LDB(B0, 1, 0); PG8_SCHED; PG8_LDA(At, 1, 0); PG8_STAGE(PG8_SA(0, 1), a2 + hstep, voffA);
            PG8_WAIT_L(8); PG8_BAR; PG8_WAIT_L(0); PG8_MMA(0, 0, At, B0); PG8_BAR; PG8_SCHED;
            PG8_LDB(B1, 1, 1); PG8_STAGE(PG8_SB(1, 0), b3, voffB);
            PG8_BAR; PG8_WAIT_L(0); PG8_MMA(0, 1, At, B1); PG8_BAR;
            PG8_LDA(At, 1, 1); PG8_STAGE(PG8_SA(1, 0), a3, voffA);
            PG8_BAR; PG8_WAIT_L(0); PG8_MMA(1, 0, At, B0); PG8_BAR; PG8_SCHED;
            PG8_STAGE(PG8_SB(1, 1), b3 + hstep, voffB);
            PG8_WAIT_V(6); PG8_BAR; PG8_MMA(1, 1, At, B1); PG8_BAR;
            }
        }
        if constexpr (ALIGN_EPI) { if (wr == 0) PG8_BAR; }
        if constexpr (!Epi::AFTER_DRAIN) { E(acc, cur, wr, wc, fr, fq); S.done(cur); }
        if (!has_next) break;
#pragma unroll
        for (int a = 0; a < 2; ++a)
#pragma unroll
            for (int b = 0; b < 2; ++b)
#pragma unroll
                for (int m = 0; m < 4; ++m)
#pragma unroll
                    for (int n = 0; n < 2; ++n) acc[a][b][m][n] = (f32x4){0.f, 0.f, 0.f, 0.f};
        cur = nxt; cA = nA; cB = nB; ++ui;
        if constexpr (ALIGN_EPI) { if (wr == 1) PG8_BAR; }
    }
    PG8_WAIT_V(0);
    if constexpr (!ALIGN_EPI) { if (wr == 0) PG8_BAR; }
    PG8_BAR;
    if constexpr (Epi::AFTER_DRAIN) { E.fused(acc, cur, wr, wc, fr, fq, lds, wid, lane); S.done(cur); }
#undef PG8_SA
#undef PG8_SB
#undef PG8_STAGE
#undef PG8_LDA
#undef PG8_LDB
#undef PG8_MMA
#undef PG8_WAIT_V
#undef PG8_WAIT_L
#undef PG8_BAR
#undef PG8_SCHED
}
}

constexpr int NWV = 8;
constexpr int BATCH = 8, SEQ = 4096, DM = 1024, MTOK = BATCH * SEQ;
constexpr int PRW_LD = 2048, QKV_LD = 2304, N1 = 6400;
constexpr int RWC = 1824, KLORA = 384, NLORA = 1536, DFF = 3072;
constexpr float NEPS = 1e-6f;
constexpr float LOG2E = 1.4426950408889634f;
constexpr size_t HM = 512 * 1024;
constexpr size_t OFF_W1T = 0, OFF_WLORA = 25 * HM, OFF_WA = 28 * HM, OFF_WB = 30 * HM, OFF_WOUT = 31 * HM, OFF_WUP = 35 * HM, OFF_WDN = 59 * HM, OFF_WPG = 71 * HM, OFF_WPLE = 75 * HM;
constexpr size_t OFF_RS0 = 76 * HM, OFF_RSPA = 77 * HM, OFF_RSPB = 81 * HM, OFF_RK = 85 * HM, OFF_ALSE = 87 * HM, OFF_PB = 90 * HM, OFF_XB = 122 * HM, OFF_BIG = 250 * HM;
constexpr size_t OFF_PRW = OFF_BIG, OFF_QKV = 506 * HM, OFF_LW = 794 * HM, OFF_AA = 858 * HM, OFF_GG = 922 * HM;
constexpr size_t OFF_ALORA = OFF_XB, OFF_YRAW = OFF_XB, OFF_YA = OFF_LW, OFF_YB = OFF_AA, OFF_MERGED = OFF_PRW, OFF_U = OFF_BIG, OFF_HMID = 634 * HM, OFF_PL = OFF_BIG;
constexpr size_t OFF_UA = 378 * HM, OFF_UB = 392 * HM;
constexpr size_t OFF_CTL = 1018 * HM, CTL_BYTES = 65536;
constexpr size_t WS_NEED = OFF_CTL + CTL_BYTES;
constexpr int LDS_BYTES = 147456;
constexpr int N_PHASES = 15;
constexpr int SCAN_BLOCKS = 128;

#define LAS __attribute__((address_space(3)))
typedef unsigned short bf16_t;
typedef float f32x4 __attribute__((ext_vector_type(4)));
typedef unsigned u32x4 __attribute__((ext_vector_type(4)));
typedef unsigned u32x2 __attribute__((ext_vector_type(2)));
typedef short bf16x8 __attribute__((ext_vector_type(8)));
typedef float f32x16 __attribute__((ext_vector_type(16)));
#define LDS_WAIT() asm volatile("s_waitcnt lgkmcnt(0)" ::: "memory")

__device__ __forceinline__ float bf2f(unsigned h) { return __uint_as_float(h << 16); }
__device__ __forceinline__ float bflo(unsigned w) { return __uint_as_float(w << 16); }
__device__ __forceinline__ float bfhi(unsigned w) { return __uint_as_float(w & 0xffff0000u); }
__device__ __forceinline__ unsigned f2bf(float f) { unsigned u = __float_as_uint(f); return (u + 0x7fffu + ((u >> 16) & 1u)) >> 16; }
__device__ __forceinline__ unsigned pk2(float lo, float hi) { return f2bf(lo) | (f2bf(hi) << 16); }
__device__ __forceinline__ float sigmoidf_(float x) { return __builtin_amdgcn_rcpf(1.0f + __expf(-x)); }
__device__ __forceinline__ float dpp_add(float x, const int ctrl_sel) {
    int t;
    if (ctrl_sel == 0) t = __builtin_amdgcn_update_dpp(0, __float_as_int(x), 0xB1, 0xf, 0xf, true);
    else if (ctrl_sel == 1) t = __builtin_amdgcn_update_dpp(0, __float_as_int(x), 0x4E, 0xf, 0xf, true);
    else if (ctrl_sel == 2) t = __builtin_amdgcn_update_dpp(0, __float_as_int(x), 0x141, 0xf, 0xf, true);
    else t = __builtin_amdgcn_update_dpp(0, __float_as_int(x), 0x140, 0xf, 0xf, true);
    return x + __int_as_float(t);
}
__device__ __forceinline__ float allsum16(float x) { x = dpp_add(x, 0); x = dpp_add(x, 1); x = dpp_add(x, 2); x = dpp_add(x, 3); return x; }
__device__ __forceinline__ float allsum8(float x) { x = dpp_add(x, 0); x = dpp_add(x, 1); x = dpp_add(x, 2); return x; }
__device__ __forceinline__ float wave_sum(float v) {
    v = allsum16(v);
    const float s0 = __int_as_float(__builtin_amdgcn_readlane(__float_as_int(v), 0)), s1 = __int_as_float(__builtin_amdgcn_readlane(__float_as_int(v), 16));
    const float s2 = __int_as_float(__builtin_amdgcn_readlane(__float_as_int(v), 32)), s3 = __int_as_float(__builtin_amdgcn_readlane(__float_as_int(v), 48));
    return (s0 + s1) + (s2 + s3);
}
__device__ __forceinline__ void unpack8(const u32x4 w, float (&f)[8]) { f[0] = bflo(w.x); f[1] = bfhi(w.x); f[2] = bflo(w.y); f[3] = bfhi(w.y); f[4] = bflo(w.z); f[5] = bfhi(w.z); f[6] = bflo(w.w); f[7] = bfhi(w.w); }
__device__ __forceinline__ u32x4 pack8(const float (&f)[8]) { u32x4 w; w.x = pk2(f[0], f[1]); w.y = pk2(f[2], f[3]); w.z = pk2(f[4], f[5]); w.w = pk2(f[6], f[7]); return w; }

__device__ __forceinline__ float gelu_tanh(float x) { const float z = x * (-2.3022082f + (-0.1029432f) * (x * x)); return x * __builtin_amdgcn_rcpf(1.0f + __builtin_amdgcn_exp2f(z)); }
struct Args { const float* in[29]; float* out; unsigned char* ws; int ph_lo, ph_hi; };

#define EPI_ROWS(...) _Pragma("unroll") for (int ai = 0; ai < 2; ++ai) _Pragma("unroll") for (int m = 0; m < 4; ++m) { const int row = row0 + ai * 128 + m * 16; __VA_ARGS__ asm volatile("" ::: "memory"); }
typedef float f32x2c_t __attribute__((ext_vector_type(2))); typedef __bf16 bf16x2c_t __attribute__((ext_vector_type(2)));
__device__ __forceinline__ unsigned cvtpk_c(float lo, float hi) { const f32x2c_t v = {lo, hi}; const bf16x2c_t b = __builtin_convertvector(v, bf16x2c_t); return __builtin_bit_cast(unsigned, b); }
__device__ __forceinline__ u32x4 pack_acc8(const f32x4 v0, const f32x4 v1) { u32x4 w; w.x = cvtpk_c(v0[0], v0[1]); w.y = cvtpk_c(v0[2], v0[3]); w.z = cvtpk_c(v1[0], v1[1]); w.w = cvtpk_c(v1[2], v1[3]); return w; }
__device__ __forceinline__ float rstd16(const float* rsp, int row) {
    const f32x4* p = (const f32x4*)(rsp + (size_t)row * 16); const f32x4 a = p[0], b = p[1], c = p[2], d = p[3];
    const float s = (((a[0] + a[1]) + (a[2] + a[3])) + ((b[0] + b[1]) + (b[2] + b[3]))) + (((c[0] + c[1]) + (c[2] + c[3])) + ((d[0] + d[1]) + (d[2] + d[3])));
    return rsqrtf(s * (1.0f / DM) + NEPS);
}

struct EpiG1 {
    static constexpr bool PERM = true, AFTER_DRAIN = false;
    bf16_t* prw; bf16_t* qkv; bf16_t* gate; const float* rs0; const float* bg;
    __device__ __forceinline__ void operator()(const f32x4 (&acc)[2][2][4][2], const pg8::Unit& u, int wr, int wc, int fr, int fq) const {
        const int row0 = u.pm * 256 + wr * 64 + fr, ct = wc * 32 + 8 * fq;
        bf16_t* base; int ld, coff; const bool isg = u.pn >= 17;
        if (u.pn < 8) { base = prw; ld = PRW_LD; coff = u.pn * 256; } else if (u.pn < 17) { base = qkv; ld = QKV_LD; coff = (u.pn - 8) * 256; } else { base = gate; ld = 2048; coff = (u.pn - 17) * 256; }
        f32x4 bv[2][2];
#pragma unroll
        for (int bj = 0; bj < 2; ++bj)
#pragma unroll
            for (int n = 0; n < 2; ++n) bv[bj][n] = isg ? *(const f32x4*)(bg + coff + ct + bj * 128 + 4 * n) : (f32x4){0.f, 0.f, 0.f, 0.f};
        EPI_ROWS(
            const float rs = rs0[row]; bf16_t* rp = base + (size_t)row * ld + coff + ct;
            _Pragma("unroll") for (int bj = 0; bj < 2; ++bj) { f32x4 v0 = acc[ai][bj][m][0] * rs, v1 = acc[ai][bj][m][1] * rs;
                if (isg) { v0 = v0 + bv[bj][0]; v1 = v1 + bv[bj][1];
                    _Pragma("unroll") for (int e = 0; e < 4; ++e) { v0[e] = sigmoidf_(v0[e]); v1[e] = sigmoidf_(v1[e]); } }
                __builtin_nontemporal_store(pack_acc8(v0, v1), (u32x4*)(rp + bj * 128)); }
        )
    }
};
__device__ __forceinline__ float lwf(float x) { const float z = -x; const float sp = fmaxf(z, 0.f) + __logf(1.0f + __expf(-fabsf(z))); return -__expf(-sp - 0.5f); }
struct EpiLora {
    static constexpr bool PERM = true, AFTER_DRAIN = false;
    bf16_t* lw; bf16_t* gg; const float* w0; const float* a0;
    __device__ __forceinline__ void operator()(const f32x4 (&acc)[2][2][4][2], const pg8::Unit& u, int wr, int wc, int fr, int fq) const {
        const int row0 = u.pm * 256 + wr * 64 + fr, ct = wc * 32 + 8 * fq; const bool first = u.pn < 4;
        bf16_t* base = (first ? lw + u.pn * 256 : gg + (u.pn - 4) * 256) + ct; const int ld = first ? 1024 : 512;
        const float* bsrc = (u.pn < 2 ? w0 + u.pn * 256 : a0 + (u.pn & 1) * 256) + ct;
        f32x4 bv[2][2];
#pragma unroll
        for (int bj = 0; bj < 2; ++bj)
#pragma unroll
            for (int n = 0; n < 2; ++n) bv[bj][n] = first ? *(const f32x4*)(bsrc + bj * 128 + 4 * n) : (f32x4){0.f, 0.f, 0.f, 0.f};
        EPI_ROWS(
            bf16_t* rp = base + (size_t)row * ld;
            _Pragma("unroll") for (int bj = 0; bj < 2; ++bj) { f32x4 v0 = acc[ai][bj][m][0], v1 = acc[ai][bj][m][1];
                if (first) { v0 = v0 + bv[bj][0]; v1 = v1 + bv[bj][1];
                    _Pragma("unroll") for (int e = 0; e < 4; ++e) { v0[e] = sigmoidf_(v0[e]); v1[e] = sigmoidf_(v1[e]); } }
                *(u32x4*)(rp + bj * 128) = pack_acc8(v0, v1); }
        )
    }
};
template <int WHICH> struct EpiBranch {
    static constexpr bool PERM = true, AFTER_DRAIN = false;
    bf16_t* merged; const bf16_t* gate;
    __device__ __forceinline__ void operator()(const f32x4 (&acc)[2][2][4][2], const pg8::Unit& u, int wr, int wc, int fr, int fq) const {
        const int row0 = u.pm * 256 + wr * 64 + fr, ct = u.pn * 256 + wc * 32 + 8 * fq;
        EPI_ROWS(
            bf16_t* rp = merged + (size_t)row * DM + ct; const bf16_t* gp = gate + (size_t)row * 2048 + WHICH * 1024 + ct;
            _Pragma("unroll") for (int bj = 0; bj < 2; ++bj) { float gv[8]; unpack8(*(const u32x4*)(gp + bj * 128), gv);
                f32x4 v0 = acc[ai][bj][m][0], v1 = acc[ai][bj][m][1];
                _Pragma("unroll") for (int e = 0; e < 4; ++e) { v0[e] *= gv[e]; v1[e] *= gv[4 + e]; }
                if (WHICH == 1) { float tv[8]; unpack8(*(const u32x4*)(rp + bj * 128), tv);
                    _Pragma("unroll") for (int e = 0; e < 4; ++e) { v0[e] += tv[e]; v1[e] += tv[4 + e]; } }
                *(u32x4*)(rp + bj * 128) = pack_acc8(v0, v1); }
        )
    }
};
template <int MODE, bool RES_BF16> struct EpiRes {
    static constexpr bool PERM = true, AFTER_DRAIN = false;
    const float* res; const bf16_t* resb; bf16_t* xb; float* rsp_out; const float* rsp_in; const bf16_t* pl;
    __device__ __forceinline__ void operator()(const f32x4 (&acc)[2][2][4][2], const pg8::Unit& u, int wr, int wc, int fr, int fq) const {
        const int row0 = u.pm * 256 + wr * 64 + fr, ct = u.pn * 256 + wc * 32 + 8 * fq;
        EPI_ROWS(
            const size_t ro = (size_t)row * DM + ct; float q = 0.f; float rs = 1.f; if (MODE == 1) rs = rstd16(rsp_in, row);
            _Pragma("unroll") for (int bj = 0; bj < 2; ++bj) { f32x4 v0 = acc[ai][bj][m][0], v1 = acc[ai][bj][m][1];
                if (MODE == 1) { float pv[8]; unpack8(*(const u32x4*)(pl + ro + bj * 128), pv);
                    _Pragma("unroll") for (int e = 0; e < 4; ++e) { v0[e] = sigmoidf_(v0[e] * rs) * pv[e]; v1[e] = sigmoidf_(v1[e] * rs) * pv[4 + e]; } }
                if (RES_BF16) { float rv[8]; unpack8(*(const u32x4*)(resb + ro + bj * 128), rv);
                    _Pragma("unroll") for (int e = 0; e < 4; ++e) { v0[e] += rv[e]; v1[e] += rv[4 + e]; } }
                else { const f32x4 r0 = *(const f32x4*)(res + ro + bj * 128), r1 = *(const f32x4*)(res + ro + bj * 128 + 4); v0 = v0 + r0; v1 = v1 + r1; }
                *(u32x4*)(xb + ro + bj * 128) = pack_acc8(v0, v1);
                q += ((v0[0] * v0[0] + v0[1] * v0[1]) + (v0[2] * v0[2] + v0[3] * v0[3])) + ((v1[0] * v1[0] + v1[1] * v1[1]) + (v1[2] * v1[2] + v1[3] * v1[3])); }
            q += __shfl_xor(q, 16); q += __shfl_xor(q, 32);
            if (fq == 0) rsp_out[(size_t)row * 16 + u.pn * 4 + wc] = q;
        )
    }
};
struct EpiUp {
    static constexpr bool PERM = true, AFTER_DRAIN = false;
    bf16_t* U; const float* rsp; int rowbase;
    __device__ __forceinline__ void operator()(const f32x4 (&acc)[2][2][4][2], const pg8::Unit& u, int wr, int wc, int fr, int fq) const {
        const int row0 = u.pm * 256 + wr * 64 + fr, ct = u.pn * 256 + wc * 32 + 8 * fq;
        EPI_ROWS(
            const float rs = rstd16(rsp, rowbase + row); bf16_t* rp = U + (size_t)row * 6144 + ct;
            _Pragma("unroll") for (int bj = 0; bj < 2; ++bj) *(u32x4*)(rp + bj * 128) = pack_acc8(acc[ai][bj][m][0] * rs, acc[ai][bj][m][1] * rs);
        )
    }
};
struct UpOrder : pg8::StaticOrder {
    __device__ __forceinline__ long arow(int pm) const { return (long)(pm / 17) * SEQ + 254 * (pm % 17) - 2; }
};
template <int CTRL> __device__ __forceinline__ float dppf(float x) { return __int_as_float(__builtin_amdgcn_update_dpp(0, __float_as_int(x), CTRL, 0xf, 0xf, true)); }
struct EpiUpGlu {
    static constexpr bool PERM = true, AFTER_DRAIN = false;
    bf16_t* hmid; const float* rsp; const float* cw; const float* cb; LAS float* xch; float* ua; float* ub;
    __device__ __forceinline__ void operator()(f32x4 (&acc)[2][2][4][2], const pg8::Unit& u, int wr, int wc, int fr, int fq) const {
        const int rowt = u.pm * 256;
        const int rho0 = wr * 64 + fr, ct = wc * 32 + 8 * fq;
#pragma unroll
        for (int ai = 0; ai < 2; ++ai)
#pragma unroll
            for (int m = 0; m < 4; ++m) { const float rs = rstd16(rsp, rowt + rho0 + ai * 128 + m * 16);
#pragma unroll
                for (int bj = 0; bj < 2; ++bj) { acc[ai][bj][m][0] = acc[ai][bj][m][0] * rs; acc[ai][bj][m][1] = acc[ai][bj][m][1] * rs; }
                asm volatile("" : "+v"(acc[ai][0][m][0]), "+v"(acc[ai][0][m][1]), "+v"(acc[ai][1][m][0]), "+v"(acc[ai][1][m][1]) :: "memory"); __builtin_amdgcn_sched_barrier(0); }
        if (fr >= 14) {
#pragma unroll
            for (int ai = 0; ai < 2; ++ai)
#pragma unroll
                for (int bj = 0; bj < 2; ++bj)
#pragma unroll
                    for (int n = 0; n < 2; ++n) *(LAS f32x4*)(xch + ((ai * 2 + wr) * 2 + (fr - 14)) * 256 + bj * 128 + ct + 4 * n) = acc[ai][bj][3][n];
            if (wr == 1) {
                float* ubp = ub + ((size_t)u.pm * 2 + (fr - 14)) * 6144 + u.pn * 256 + ct;
                *(f32x4*)(ubp) = acc[1][0][3][0]; *(f32x4*)(ubp + 4) = acc[1][0][3][1]; *(f32x4*)(ubp + 128) = acc[1][1][3][0]; *(f32x4*)(ubp + 132) = acc[1][1][3][1];
            }
        }
        if (wr == 0 && fr < 2) {
            float* uap = ua + ((size_t)u.pm * 2 + fr) * 6144 + u.pn * 256 + ct;
            *(f32x4*)(uap) = acc[0][0][0][0]; *(f32x4*)(uap + 4) = acc[0][0][0][1]; *(f32x4*)(uap + 128) = acc[0][1][0][0]; *(f32x4*)(uap + 132) = acc[0][1][0][1];
        }
        __builtin_amdgcn_sched_barrier(0);
        asm volatile("s_waitcnt lgkmcnt(0)" ::: "memory"); __builtin_amdgcn_s_barrier(); asm volatile("" ::: "memory");
        const float m1 = (fr == 0) ? 1.f : 0.f, m2 = (fr < 2) ? 1.f : 0.f;
#pragma unroll
        for (int n = 0; n < 2; ++n) {
#pragma unroll
            for (int bj = 0; bj < 2; ++bj) {
                const int col = bj * 3072 + u.pn * 128 + ct + 4 * n;
                const f32x4 c0 = *(const f32x4*)(cw + col), c1 = *(const f32x4*)(cw + 6144 + col), c2 = *(const f32x4*)(cw + 2 * 6144 + col), cbv = *(const f32x4*)(cb + col);
                const f32x4 c1m = c1 * m1, c2m = c2 * m2;
#pragma unroll
                for (int ai = 0; ai < 2; ++ai) {
                    const int seg = ai * 2 + wr;
                    f32x4 X = {0.f, 0.f, 0.f, 0.f};
                    if (seg > 0) X = *(const LAS f32x4*)(xch + ((seg - 1) * 2 + (fr & 1)) * 256 + bj * 128 + ct + 4 * n);
#pragma unroll
                    for (int m = 3; m >= 0; --m) {
                        f32x4 v = acc[ai][bj][m][n]; f32x4 vp = (m > 0) ? acc[ai][bj][m > 0 ? m - 1 : 0][n] : X; f32x4 o;
                        asm volatile("" : "+v"(v), "+v"(vp));
#pragma unroll
                        for (int e = 0; e < 4; ++e) {
                            float r = cbv[e] + c0[e] * v[e];
                            r += c1[e] * dppf<0x111>(v[e]); r += c1m[e] * dppf<0x121>(vp[e]);
                            r += c2[e] * dppf<0x112>(v[e]); r += c2m[e] * dppf<0x122>(vp[e]);
                            o[e] = r; }
                        asm volatile("" : "+v"(o));
                        acc[ai][bj][m][n] = o;
                        __builtin_amdgcn_sched_barrier(0);
                    }
                }
            }
#pragma unroll
            for (int ai = 0; ai < 2; ++ai)
#pragma unroll
                for (int m = 0; m < 4; ++m) { f32x4 gv = acc[ai][0][m][n]; const f32x4 vv = acc[ai][1][m][n];
#pragma unroll
                    for (int e = 0; e < 4; ++e) gv[e] = gelu_tanh(gv[e]) * vv[e];
                    asm volatile("" : "+v"(gv));
                    acc[ai][0][m][n] = gv; __builtin_amdgcn_sched_barrier(0); }
        }
#pragma unroll
        for (int ai = 0; ai < 2; ++ai)
#pragma unroll
            for (int m = 0; m < 4; ++m) { const int rho = rho0 + ai * 128 + m * 16;
                if (rho >= 2) __builtin_nontemporal_store(pack_acc8(acc[ai][0][m][0], acc[ai][0][m][1]), (u32x4*)(hmid + ((size_t)rowt + rho) * DFF + u.pn * 128 + ct));
                asm volatile("" ::: "memory"); __builtin_amdgcn_sched_barrier(0); }
    }
};
struct EpiPlain {
    static constexpr bool PERM = true, AFTER_DRAIN = false;
    bf16_t* O; int ld;
    __device__ __forceinline__ void operator()(const f32x4 (&acc)[2][2][4][2], const pg8::Unit& u, int wr, int wc, int fr, int fq) const {
        const int row0 = u.pm * 256 + wr * 64 + fr, ct = u.pn * 256 + wc * 32 + 8 * fq;
        EPI_ROWS(
            bf16_t* rp = O + (size_t)row * ld + ct;
            _Pragma("unroll") for (int bj = 0; bj < 2; ++bj) *(u32x4*)(rp + bj * 128) = pack_acc8(acc[ai][bj][m][0], acc[ai][bj][m][1]);
        )
    }
};

__device__ __forceinline__ void tr_item(const float* __restrict__ W, int ldw, int k0, int n0, const float* __restrict__ g, bf16_t* WT, int ldd, int drow0, LAS float* scr, int lane) {
    f32x4 wv[8];
#pragma unroll
    for (int i = 0; i < 8; ++i) wv[i] = __builtin_nontemporal_load((const f32x4*)(W + (size_t)(k0 + 8 * i + (lane >> 3)) * ldw + n0 + 4 * (lane & 7)));
#pragma unroll
    for (int i = 0; i < 8; ++i) { const int kk = 8 * i + (lane >> 3); f32x4 v = wv[i]; if (g) v = v * g[k0 + kk];
        LAS float* sp = scr + kk * 33 + 4 * (lane & 7); sp[0] = v[0]; sp[1] = v[1]; sp[2] = v[2]; sp[3] = v[3]; }
    LDS_WAIT();
    const int c = lane & 7;
#pragma unroll
    for (int j = 0; j < 4; ++j) { const int n = (lane >> 3) + 8 * j; const LAS float* s = scr + (8 * c) * 33 + n;
        u32x4 o; o.x = pk2(s[0 * 33], s[1 * 33]); o.y = pk2(s[2 * 33], s[3 * 33]); o.z = pk2(s[4 * 33], s[5 * 33]); o.w = pk2(s[6 * 33], s[7 * 33]);
        *(u32x4*)(WT + (size_t)(drow0 + n) * ldd + k0 + 8 * c) = o; }
    LDS_WAIT();
}
__device__ __forceinline__ void tr_matrix_item(const float* W, int K, int N, const float* g, bf16_t* WT, int r, LAS float* scr, int lane) {
    const int nblk = N / 32, kb = r / nblk, nb = r % nblk; tr_item(W, N, 64 * kb, 32 * nb, g, WT, K, 32 * nb, scr, lane);
}

__device__ __forceinline__ int crow(int r, int hi) { return (r & 3) + 8 * (r >> 2) + 4 * hi; }
typedef short v4i16_t __attribute__((ext_vector_type(4)));
__device__ __forceinline__ void attn_unit(bf16_t* QKV, float* ALSE, int unit, int lane, LAS unsigned char* vlds  , int do_store = 1) {
    const int g = unit >> 12, rem = unit & 4095, b = rem >> 9, hg = (rem >> 7) & 3, tile = rem & 127;
    const int d = (g == 0) ? 1 : ((g == 1) ? 4 : 16), tps = 128 / d, r = tile / tps, qt = tile % tps, i0 = 32 * qt;
    const int h = g * 4 + hg;
    const float slope = exp2f(-8.0f * (float)(h + 1) / 12.0f);
    const float c1 = 0.125f * LOG2E, c2 = slope * (float)d * LOG2E;
    const int qq = lane & 31, hi = lane >> 5;
    const size_t rowq = (size_t)b * SEQ + r + (size_t)d * (i0 + qq);
    bf16_t* qptr = QKV + rowq * QKV_LD + h * 64;
    bf16x8 qf[4];
#pragma unroll
    for (int ds = 0; ds < 4; ++ds) qf[ds] = *(const bf16x8*)(qptr + 16 * ds + 8 * hi);
    const bf16_t* Kb = QKV + ((size_t)b * SEQ + r) * QKV_LD + 768 + h * 64;
    const bf16_t* Vb = QKV + ((size_t)b * SEQ + r) * QKV_LD + 1536 + h * 64;
    float m_run = -1e30f, l_run = 0.f;
    f32x16 o0, o1;
#pragma unroll
    for (int i = 0; i < 16; ++i) { o0[i] = 0.f; o1[i] = 0.f; }
    for (int kt = 0; kt < 5; ++kt) {
        const int kb = i0 - 128 + 32 * kt;
        if (kb + 31 < 0) continue;
        const int ik = kb + qq, ikc = ik < 0 ? 0 : ik;
        u32x4 vreg[4];
#pragma unroll
        for (int i = 0; i < 4; ++i) { int key = kb + (lane >> 3) + 8 * i; key = key < 0 ? 0 : key; vreg[i] = *(const u32x4*)(Vb + (size_t)d * key * QKV_LD + (lane & 7) * 8); }
        const bf16_t* kp = Kb + (size_t)d * ikc * QKV_LD;
        f32x16 s;
#pragma unroll
        for (int i = 0; i < 16; ++i) s[i] = 0.f;
#pragma unroll
        for (int ds = 0; ds < 4; ++ds) { const bf16x8 kf = *(const bf16x8*)(kp + 16 * ds + 8 * hi); s = __builtin_amdgcn_mfma_f32_32x32x16_bf16(kf, qf[ds], s, 0, 0, 0); }
        float p[16]; float tmax = -1e30f;
#pragma unroll
        for (int rr = 0; rr < 16; ++rr) { const int kap = crow(rr, hi); const int st = qq + 128 - 32 * kt - kap; const bool valid = (st >= 0) && (st <= 128) && (kb + kap >= 0);
            p[rr] = valid ? (s[rr] * c1 - c2 * (float)st) : -1e30f; tmax = fmaxf(tmax, p[rr]); }
        tmax = fmaxf(tmax, __shfl_xor(tmax, 32));
        const float m_new = fmaxf(m_run, tmax), alpha = exp2f(m_run - m_new);
        float psum = 0.f;
#pragma unroll
        for (int rr = 0; rr < 16; ++rr) { p[rr] = (p[rr] > -1e29f) ? exp2f(p[rr] - m_new) : 0.f; psum += p[rr]; }
        psum += __shfl_xor(psum, 32);
        l_run = l_run * alpha + psum; m_run = m_new;
#pragma unroll
        for (int i = 0; i < 16; ++i) { o0[i] *= alpha; o1[i] *= alpha; }
#pragma unroll
        for (int i = 0; i < 4; ++i) *(LAS u32x4*)(vlds + ((lane >> 3) + 8 * i) * 128 + (lane & 7) * 16) = vreg[i];
        LDS_WAIT();
#pragma unroll
        for (int j = 0; j < 2; ++j) {
            u32x4 pw; pw.x = pk2(p[8 * j + 0], p[8 * j + 1]); pw.y = pk2(p[8 * j + 2], p[8 * j + 3]); pw.z = pk2(p[8 * j + 4], p[8 * j + 5]); pw.w = pk2(p[8 * j + 6], p[8 * j + 7]);
            const bf16x8 pf = __builtin_bit_cast(bf16x8, pw);
            const int q_ = (lane & 15) >> 2, p_ = lane & 3, blk = (lane >> 4) & 1;
            LAS unsigned char* rb = vlds + (16 * j + 4 * hi + q_) * 128 + blk * 32 + 8 * p_;
            const v4i16_t a0 = __builtin_amdgcn_ds_read_tr16_b64_v4i16((LAS v4i16_t*)(rb)), a1 = __builtin_amdgcn_ds_read_tr16_b64_v4i16((LAS v4i16_t*)(rb + 8 * 128));
            const v4i16_t b0 = __builtin_amdgcn_ds_read_tr16_b64_v4i16((LAS v4i16_t*)(rb + 64)), b1 = __builtin_amdgcn_ds_read_tr16_b64_v4i16((LAS v4i16_t*)(rb + 8 * 128 + 64));
            const bf16x8 v0 = {a0[0], a0[1], a0[2], a0[3], a1[0], a1[1], a1[2], a1[3]}, v1 = {b0[0], b0[1], b0[2], b0[3], b1[0], b1[1], b1[2], b1[3]};
            o0 = __builtin_amdgcn_mfma_f32_32x32x16_bf16(v0, pf, o0, 0, 0, 0);
            o1 = __builtin_amdgcn_mfma_f32_32x32x16_bf16(v1, pf, o1, 0, 0, 0);
        }
        LDS_WAIT();
    }
    const float inv = 1.0f / l_run;
    if (do_store) {
#pragma unroll
    for (int q4 = 0; q4 < 4; ++q4) {
        u32x2 w0, w1;
        w0.x = pk2(o0[4 * q4] * inv, o0[4 * q4 + 1] * inv); w0.y = pk2(o0[4 * q4 + 2] * inv, o0[4 * q4 + 3] * inv);
        w1.x = pk2(o1[4 * q4] * inv, o1[4 * q4 + 1] * inv); w1.y = pk2(o1[4 * q4 + 2] * inv, o1[4 * q4 + 3] * inv);
        *(u32x2*)(qptr + 8 * q4 + 4 * hi) = w0; *(u32x2*)(qptr + 32 + 8 * q4 + 4 * hi) = w1;
    }
    if (hi == 0) ALSE[((size_t)g * MTOK + rowq) * 4 + hg] = m_run + log2f(l_run);
    }
}

constexpr int SC_NB = 16;
typedef float f32x2 __attribute__((ext_vector_type(2)));
__device__ __forceinline__ void scan_block(const Args& a, LAS unsigned char* ldsb, int bx, int tid) {
    LAS float* OP = (LAS float*)ldsb;
    LAS float* VV = OP + 2 * SC_NB * 320;
    LAS float* YP = VV + 2 * SC_NB * 16;
    const int lane = tid & 63, w = tid >> 6;
    const int bh = (bx & 7) * 8 + ((bx >> 3) >> 2), qtr = (bx >> 3) & 3, b = bh >> 3, h = bh & 7;
    const bf16_t* PRW = (const bf16_t*)(a.ws + OFF_PRW); const bf16_t* LWA = (const bf16_t*)(a.ws + OFF_LW);
    float* YRAW = (float*)(a.ws + OFF_YRAW);
    const size_t mb = (size_t)b * SEQ;
    const bool is_scan = w < 4;
    const int rl = (w & 3) * 4 + (lane >> 4), j = lane & 15;
    f32x2 S01 = {0.f, 0.f}, S23 = {0.f, 0.f};
    const int pt = tid & 255, s_ = pt >> 4, k4 = (pt & 15) * 4, hc4 = h * 64 + k4;
    const f32x4 kk_c = *(const f32x4*)(a.in[10] + hc4), ka_c = *(const f32x4*)(a.in[11] + hc4), rk_c = *(const f32x4*)(a.in[12] + hc4);
    const f32x4 mu_r = *(const f32x4*)(a.in[4] + hc4), mu_k = *(const f32x4*)(a.in[4] + 512 + hc4), mu_v = *(const f32x4*)(a.in[4] + 1024 + hc4);
    float* RKB = (float*)(a.ws + OFF_RSPB);
    const float* KN = (const float*)(a.ws + OFF_RK);
    u32x2 lr[2][2], lk[2][2], lv[2][2], lw_[2], la_[2]; float kn_[2];
#define SC_LOAD(SET, nb) do { const int t = (nb) * SC_NB + s_; const bf16_t* row = PRW + (mb + t) * PRW_LD + hc4; const bf16_t* prw_ = t > 0 ? row - PRW_LD : row; \
        lr[SET][0] = *(const u32x2*)row; lr[SET][1] = *(const u32x2*)prw_; lk[SET][0] = *(const u32x2*)(row + 512); lk[SET][1] = *(const u32x2*)(prw_ + 512); \
        lv[SET][0] = *(const u32x2*)(row + 1024); lv[SET][1] = *(const u32x2*)(prw_ + 1024); \
        lw_[SET] = *(const u32x2*)(LWA + (mb + t) * 1024 + hc4); la_[SET] = *(const u32x2*)(LWA + (mb + t) * 1024 + 512 + hc4); kn_[SET] = KN[(mb + t) * 8 + h]; } while (0)
#define SC_U4(w, f) do { f[0] = bflo((w).x); f[1] = bfhi((w).x); f[2] = bflo((w).y); f[3] = bfhi((w).y); } while (0)
#define SC_PREP(SET, nb) do { LAS float* opb = OP + ((nb) & 1) * (SC_NB * 320) + s_ * 320 + k4; LAS float* vvb = VV + ((nb) & 1) * (SC_NB * 16) + s_ * 16; \
        const float tm = ((nb) * SC_NB + s_) > 0 ? 1.f : 0.f; \
        f32x4 cr, pr_, ck, pk_, cv, pv_, sw, sa_; SC_U4(lr[SET][0], cr); SC_U4(lr[SET][1], pr_); SC_U4(lk[SET][0], ck); SC_U4(lk[SET][1], pk_); SC_U4(lv[SET][0], cv); SC_U4(lv[SET][1], pv_); SC_U4(lw_[SET], sw); SC_U4(la_[SET], sa_); \
        const f32x4 r_ = cr + (pr_ * tm - cr) * mu_r, k_ = ck + (pk_ * tm - ck) * mu_k, v_ = cv + (pv_ * tm - cv) * mu_v; \
        f32x4 dec; _Pragma("unroll") for (int e = 0; e < 4; ++e) dec[e] = __expf(-0.6065306597126334f * sw[e]); \
        const f32x4 kk = k_ * kk_c * kn_[SET]; const f32x4 kp = k_ * ((sa_ - 1.0f) * ka_c + 1.0f); \
        *(LAS f32x4*)(opb) = dec; *(LAS f32x4*)(opb + 64) = -kk; *(LAS f32x4*)(opb + 128) = kk * sa_; *(LAS f32x4*)(opb + 192) = kp; *(LAS f32x4*)(opb + 256) = r_; \
        if (((pt & 15) >> 2) == qtr) *(LAS f32x4*)(vvb + (pt & 3) * 4) = v_; \
        { const f32x4 q4 = r_ * kp * rk_c; float rk = (q4[0] + q4[1]) + (q4[2] + q4[3]); rk = allsum16(rk); \
          if ((s_ & 3) == qtr && (pt & 15) == 0) RKB[(mb + (nb) * SC_NB + s_) * 8 + h] = rk; } } while (0)
#define SC_YRED(nb) do { const LAS float* ypb = YP + ((nb) & 1) * (SC_NB * 256); const int s = pt >> 4, r = pt & 15; \
        const LAS f32x4* q4 = (const LAS f32x4*)(ypb + s * 256 + r * 16); const f32x4 y0 = q4[0], y1 = q4[1], y2 = q4[2], y3 = q4[3]; \
        const float ysum = (((y0[0] + y0[1]) + (y0[2] + y0[3])) + ((y1[0] + y1[1]) + (y1[2] + y1[3]))) + (((y2[0] + y2[1]) + (y2[2] + y2[3])) + ((y3[0] + y3[1]) + (y3[2] + y3[3]))); \
        YRAW[(mb + (nb) * SC_NB + s) * 512 + h * 64 + 16 * qtr + r] = ysum; } while (0)
    constexpr int NBATCH = SEQ / SC_NB;
#if (PROBE_MASK >> 15) & 1
    int nrep_ = 2; asm volatile("" : "+s"(nrep_));
#pragma unroll 1
    for (int rep_ = 0; rep_ < nrep_; ++rep_) {
    S01 = (f32x2){0.f, 0.f}; S23 = (f32x2){0.f, 0.f};
#else
    {
#endif
    if (!is_scan) { SC_LOAD(0, 0); SC_LOAD(1, 1); SC_PREP(0, 0); SC_LOAD(0, 2); }
    __syncthreads();
    if (is_scan) __builtin_amdgcn_s_setprio(3);
#pragma unroll 1
    for (int it2 = 0; it2 < NBATCH; it2 += 2) {
#pragma unroll
        for (int par = 0; par < 2; ++par) {
            const int it = it2 + par;
            if (is_scan) {
                const LAS float* opb = OP + par * (SC_NB * 320); const LAS float* vvb = VV + par * (SC_NB * 16) + rl; LAS float* ypb = YP + par * (SC_NB * 256) + (w & 3) * 64 + lane;
                const LAS f32x4* op = (const LAS f32x4*)opb + j;
                f32x4 wv = op[0], av = op[16], bv = op[32], kv = op[48], rv = op[64]; float vv = vvb[0];
#pragma unroll
                for (int s = 0; s < SC_NB; ++s) {
                    f32x4 wn, an, bn, kn, rn; float vn;
                    if (s + 1 < SC_NB) { const LAS f32x4* opn = op + (s + 1) * 80; wn = opn[0]; an = opn[16]; bn = opn[32]; kn = opn[48]; rn = opn[64]; vn = vvb[(s + 1) * 16]; }
                    f32x2 t2 = S01 * (f32x2){av[0], av[1]}; t2 = S23 * (f32x2){av[2], av[3]} + t2;
                    float sa = t2[0] + t2[1]; sa = allsum16(sa);
                    const f32x2 sa2 = {sa, sa}, vv2 = {vv, vv};
                    S01 = (f32x2){kv[0], kv[1]} * vv2 + ((f32x2){bv[0], bv[1]} * sa2 + S01 * (f32x2){wv[0], wv[1]});
                    S23 = (f32x2){kv[2], kv[3]} * vv2 + ((f32x2){bv[2], bv[3]} * sa2 + S23 * (f32x2){wv[2], wv[3]});
                    f32x2 y2 = S01 * (f32x2){rv[0], rv[1]}; y2 = S23 * (f32x2){rv[2], rv[3]} + y2;
                    ypb[s * 256] = y2[0] + y2[1];
                    if (s + 1 < SC_NB) { wv = wn; av = an; bv = bn; kv = kn; rv = rn; vv = vn; }
                }
            } else {
                if (it >= 1) SC_YRED(it - 1);
                if (it + 1 < NBATCH) { SC_PREP(1 - par, it + 1); if (it + 3 < NBATCH) SC_LOAD(1 - par, it + 3); }
            }
            __syncthreads();
        }
    }
    __builtin_amdgcn_s_setprio(0);
    if (!is_scan) SC_YRED(NBATCH - 1);
    __syncthreads();
    }
#undef SC_LOAD
#undef SC_PREP
#undef SC_YRED
}

#define XB_TMO      128
#define XB_XCNT(j)  (256  + 64 * (j))
#define XB_XSUB(j)  (1280 + 64 * (j))
#define XB_XGEN(j)  (2304 + 64 * (j))
#define XB_TOP      3328
#define XB_TOPGEN   3392
#define XCD_BAR_WORDS 3456
#define XB_SPIN_CAP (1u << 18)

__device__ __forceinline__ unsigned xb_ld(unsigned* p)              { return __hip_atomic_load(p, __ATOMIC_RELAXED, __HIP_MEMORY_SCOPE_AGENT); }
__device__ __forceinline__ unsigned xb_add(unsigned* p, unsigned v) { return __hip_atomic_fetch_add(p, v, __ATOMIC_RELAXED, __HIP_MEMORY_SCOPE_AGENT); }
__device__ __forceinline__ unsigned xb_xcc_id() { return (unsigned)__builtin_amdgcn_s_getreg((3 << 11) | 20) & 0xFu; }
#define XB_SPIN(cond, bar) do { unsigned _sp = 0; while (cond) { __builtin_amdgcn_s_sleep(1); \
    if ((++_sp & 255u) == 0u) { if (xb_ld(&(bar)[XB_TMO])) break; if (_sp > XB_SPIN_CAP) { atomicAdd(&(bar)[XB_TMO], 1u); break; } } } } while (0)

struct XcdBarrier {
    unsigned* bar; unsigned x;
    volatile LAS unsigned* st;
};

__device__ __forceinline__ XcdBarrier xcd_barrier_post(unsigned* bar, volatile LAS unsigned* st) {
    XcdBarrier b; b.bar = bar; b.x = xb_xcc_id(); b.st = st;
    if (threadIdx.x == 0) (void)xb_add(&bar[XB_XCNT(b.x)], 1u);
    return b;
}
__device__ __forceinline__ void xcd_barrier_complete(unsigned* bar, unsigned x, unsigned& nloc, unsigned& nx) {
    const unsigned G = gridDim.x * gridDim.y * gridDim.z;
    unsigned sum, cnt, mine, sp = 0u;
    for (;;) {
        sum = 0u; cnt = 0u; mine = 0u;
#pragma unroll
        for (unsigned j = 0; j < 16; ++j) { const unsigned c = xb_ld(&bar[XB_XCNT(j)]); sum += c; cnt += (c > 0u) ? 1u : 0u; mine = (j == x) ? c : mine; }
        if (sum == G) break;
        __builtin_amdgcn_s_sleep(1);
        if ((++sp & 255u) == 0u) { if (xb_ld(&bar[XB_TMO])) break; if (sp > XB_SPIN_CAP) { atomicAdd(&bar[XB_TMO], 1u); break; } }
    }
    nloc = mine > 0u ? mine : 1u; nx = cnt > 0u ? cnt : 1u;
}

__device__ __forceinline__ void xcd_barrier(const XcdBarrier& b) {
    asm volatile("s_waitcnt vmcnt(0)" ::: "memory");
    __syncthreads();
    if (threadIdx.x == 0) {
        unsigned* bar = b.bar;
        __builtin_amdgcn_s_waitcnt(0);
        unsigned nloc = b.st[0], nx = b.st[1];
        if (nloc == 0u) { xcd_barrier_complete(bar, b.x, nloc, nx); b.st[0] = nloc; b.st[1] = nx; }
        const unsigned old = xb_add(&bar[XB_XSUB(b.x)], 1u);
        const unsigned gen = old / nloc;
        if (old + 1u == (gen + 1u) * nloc) {
            __builtin_amdgcn_fence(__ATOMIC_RELEASE, "agent");
            asm volatile("s_waitcnt vmcnt(0)" ::: "memory");
            const unsigned og = xb_add(&bar[XB_TOP], 1u);
            const unsigned tg = og / nx;
            if (og + 1u == (tg + 1u) * nx) xb_add(&bar[XB_TOPGEN], 1u);
            else XB_SPIN(xb_ld(&bar[XB_TOPGEN]) == tg, bar);
            __builtin_amdgcn_fence(__ATOMIC_ACQUIRE, "agent");
            xb_add(&bar[XB_XGEN(b.x)], 1u);
            asm volatile("s_waitcnt vmcnt(0)" ::: "memory");
        } else {
            XB_SPIN(xb_ld(&bar[XB_XGEN(b.x)]) == gen, bar);
            __builtin_amdgcn_fence(__ATOMIC_ACQUIRE, "agent");
            asm volatile("s_waitcnt vmcnt(0)" ::: "memory");
        }
    }
    __syncthreads();
}

__device__ __forceinline__ int opaque_int(int n) { asm volatile("" : "+s"(n)); return n; }

__global__ void __launch_bounds__(NWV * 64, 2) mk_fwd(Args a) {
    extern __shared__ __attribute__((aligned(16))) unsigned char lds_raw[];
    LAS unsigned char* lds = (LAS unsigned char*)lds_raw;
    const int tid = threadIdx.x, lane = tid & 63, wave = __builtin_amdgcn_readfirstlane(tid >> 6);
    const int G = gridDim.x, bx = blockIdx.x;
    const int gw = bx * NWV + wave, NGW = G * NWV;
    const int gt = bx * (NWV * 64) + tid, NGT = G * NWV * 64;
    unsigned char* ws = a.ws;
    bf16_t* W1T = (bf16_t*)(ws + OFF_W1T); bf16_t* WLORA = (bf16_t*)(ws + OFF_WLORA); bf16_t* WA = (bf16_t*)(ws + OFF_WA); bf16_t* WB = (bf16_t*)(ws + OFF_WB);
    bf16_t* WOUT = (bf16_t*)(ws + OFF_WOUT); bf16_t* WUP = (bf16_t*)(ws + OFF_WUP); bf16_t* WDN = (bf16_t*)(ws + OFF_WDN); bf16_t* WPG = (bf16_t*)(ws + OFF_WPG); bf16_t* WPLE = (bf16_t*)(ws + OFF_WPLE);
    float* RS0 = (float*)(ws + OFF_RS0); float* RSPA = (float*)(ws + OFF_RSPA); float* RSPB = (float*)(ws + OFF_RSPB); float* RK = (float*)(ws + OFF_RK); float* ALSE = (float*)(ws + OFF_ALSE);
    bf16_t* PB = (bf16_t*)(ws + OFF_PB); bf16_t* XB = (bf16_t*)(ws + OFF_XB); bf16_t* PRW = (bf16_t*)(ws + OFF_PRW); bf16_t* QKV = (bf16_t*)(ws + OFF_QKV);
    bf16_t* LW = (bf16_t*)(ws + OFF_LW); bf16_t* AA = (bf16_t*)(ws + OFF_AA); bf16_t* GG = (bf16_t*)(ws + OFF_GG); bf16_t* ALORA = (bf16_t*)(ws + OFF_ALORA);
    float* YRAW = (float*)(ws + OFF_YRAW); bf16_t* YA = (bf16_t*)(ws + OFF_YA); bf16_t* YB = (bf16_t*)(ws + OFF_YB); bf16_t* MERGED = (bf16_t*)(ws + OFF_MERGED);
    bf16_t* UU = (bf16_t*)(ws + OFF_U); bf16_t* HMID = (bf16_t*)(ws + OFF_HMID); bf16_t* PL = (bf16_t*)(ws + OFF_PL);
    bf16_t* GATE = (bf16_t*)a.out;
    const int lo = a.ph_lo, hi = a.ph_hi;
    XcdBarrier xbar; xbar.bar = (unsigned*)(ws + OFF_CTL); xbar.x = 0; xbar.st = nullptr;
    if (hi - lo > 2) {
        if (tid < 2) ((volatile LAS unsigned*)(lds + 131072 + 512))[tid] = 0u;
        __syncthreads();
        xbar = xcd_barrier_post((unsigned*)(ws + OFF_CTL), (volatile LAS unsigned*)(lds + 131072 + 512));
        cg::this_grid().sync();
    }
#ifndef ONLY_PHASE
#define ONLY_PHASE -1
#endif
#ifndef PROBE_MASK
#define PROBE_MASK 0
#endif
#define REPS(k) ((((PROBE_MASK >> (k)) & 1) != 0) ? opaque_int(2) : 1)
#define IN(k) ((ONLY_PHASE < 0 || ONLY_PHASE == (k) || (ONLY_PHASE == 8 && (k) == 10) || (ONLY_PHASE == 9 && (k) == 11)) && lo <= (k) && (k) < hi)
#if (PROBE_MASK >> 13) & 1
#define SEAM(k) do { if (IN(k) && IN((k) + 1)) { xcd_barrier(xbar); xcd_barrier(xbar); } } while (0)
#else
#define SEAM(k) do { if (IN(k) && IN((k) + 1)) xcd_barrier(xbar); } while (0)
#endif

    if (IN(0)) for (int rep_ = 0; rep_ < REPS(0); ++rep_) {
        LAS float* scr = (LAS float*)(lds + wave * 16384);
        constexpr int I_WIN = 16 * 129, I_WG = 16 * 64;
        for (int it = gw; it < I_WIN + I_WG; it += NGW) {
            int r = it;
            if (r < I_WIN) { const int kb = r / 129, nb = r % 129, n0 = 32 * nb; tr_item(a.in[3], 4128, 64 * kb, n0, a.in[2], W1T, DM, n0 < RWC ? n0 : n0 + 224, scr, lane); continue; } r -= I_WIN;
            { const int kb = r / 64, nb = r % 64; tr_item(a.in[17], 2048, 64 * kb, 32 * nb, a.in[2], W1T, DM, 4352 + 32 * nb, scr, lane); }
        }
        for (int e = gt; e < 224 * DM / 8; e += NGT) *(u32x4*)(W1T + (size_t)RWC * DM + (size_t)e * 8) = (u32x4){0u, 0u, 0u, 0u};
        for (int m0 = gw * 4; m0 < MTOK; m0 += NGW * 4) {
            f32x4 v[4][4];
#pragma unroll
            for (int r = 0; r < 4; ++r) { const f32x4* xr = (const f32x4*)(a.in[0] + (size_t)(m0 + r) * DM) + lane;
#pragma unroll
                for (int jj = 0; jj < 4; ++jj) v[r][jj] = __builtin_nontemporal_load(xr + 64 * jj); }
#pragma unroll
            for (int r = 0; r < 4; ++r) { float sq = 0.f;
#pragma unroll
                for (int jj = 0; jj < 4; ++jj) sq += (v[r][jj][0] * v[r][jj][0] + v[r][jj][1] * v[r][jj][1]) + (v[r][jj][2] * v[r][jj][2] + v[r][jj][3] * v[r][jj][3]);
                sq = wave_sum(sq); if (lane == 0) RS0[m0 + r] = rsqrtf(sq * (1.0f / DM) + NEPS);
                u32x2* o8 = (u32x2*)(XB + (size_t)(m0 + r) * DM) + lane;
#pragma unroll
                for (int jj = 0; jj < 4; ++jj) { u32x2 o; o.x = pk2(v[r][jj][0], v[r][jj][1]); o.y = pk2(v[r][jj][2], v[r][jj][3]); o8[64 * jj] = o; } }
        }
        __syncthreads();
    }
    SEAM(0);
    if (IN(1)) for (int rep_ = 0; rep_ < REPS(1); ++rep_) {
        pg8::Gemm g{XB, W1T, MTOK, N1, DM}; pg8::StaticOrder S; S.init(MTOK, N1, G, bx);
        EpiG1 E{PRW, QKV, GATE, RS0, a.in[18]};
        pg8::gemm_phase<EpiG1, pg8::StaticOrder, true, true>(lds, g, S, E);
        if (bx >= 128 && G == 256) {
            const int gw2 = (bx - 128) * NWV + wave, NGW2 = 128 * NWV, gt2 = (bx - 128) * (NWV * 64) + tid, NGT2 = 128 * NWV * 64;
            LAS float* scr = (LAS float*)(lds + wave * 16384);
            constexpr int I_WA = 8 * 32, I_WB = 4 * 32, I_WO = 16 * 32, I_WUP = 16 * 192, I_WD = 48 * 32, I_WPG = 16 * 32, I_WPLE = 4 * 32;
            constexpr int NIT2 = I_WA + I_WB + I_WO + I_WUP + I_WD + I_WPG + I_WPLE;
            for (int it = gw2; it < NIT2; it += NGW2) {
                int r = it;
                if (r < I_WA) { tr_matrix_item(a.in[15], 512, DM, nullptr, WA, r, scr, lane); continue; } r -= I_WA;
                if (r < I_WB) { tr_matrix_item(a.in[16], 256, DM, nullptr, WB, r, scr, lane); continue; } r -= I_WB;
                if (r < I_WO) { tr_matrix_item(a.in[19], DM, DM, nullptr, WOUT, r, scr, lane); continue; } r -= I_WO;
                if (r < I_WUP) { const int kb = r / 192, nb = r % 192, n0 = 32 * nb, jj = n0 < DFF ? n0 : n0 - DFF;
                    tr_item(a.in[21], 6144, 64 * kb, n0, a.in[20], WUP, DM, (jj / 128) * 256 + (n0 < DFF ? 0 : 128) + (jj % 128), scr, lane); continue; } r -= I_WUP;
                if (r < I_WD) { tr_matrix_item(a.in[24], DFF, DM, nullptr, WDN, r, scr, lane); continue; } r -= I_WD;
                if (r < I_WPG) { tr_matrix_item(a.in[26], DM, DM, a.in[25], WPG, r, scr, lane); continue; } r -= I_WPG;
                tr_matrix_item(a.in[27], 256, DM, nullptr, WPLE, r, scr, lane);
            }
            for (int e = gt2; e < NLORA * KLORA; e += NGT2) { const int n = e / KLORA, k = e % KLORA; float v = 0.f;
                if (n < 512) { if (k < 64) v = a.in[6][k * 512 + n]; } else if (n < 1024) { if (k >= 64 && k < 128) v = a.in[8][(k - 64) * 512 + (n - 512)]; } else { if (k >= 128 && k < 288) v = a.in[9][(k - 128) * 512 + (n - 1024)]; }
                WLORA[e] = (bf16_t)f2bf(v); }
        for (int c0 = gt2; c0 < MTOK * 256 / 8; c0 += NGT2 * 4) {
            f32x4 p0[4], p1[4];
#pragma unroll
            for (int r = 0; r < 4; ++r) { const int c = c0 + r * NGT2; if (c < MTOK * 256 / 8) { const f32x4* pp = (const f32x4*)(a.in[1] + (size_t)c * 8); p0[r] = __builtin_nontemporal_load(pp); p1[r] = __builtin_nontemporal_load(pp + 1); } }
#pragma unroll
            for (int r = 0; r < 4; ++r) { const int c = c0 + r * NGT2; if (c < MTOK * 256 / 8) { u32x4 o; o.x = pk2(p0[r][0], p0[r][1]); o.y = pk2(p0[r][2], p0[r][3]); o.z = pk2(p1[r][0], p1[r][1]); o.w = pk2(p1[r][2], p1[r][3]); *(u32x4*)(PB + (size_t)c * 8) = o; } }
        }
            __syncthreads();
        }
    }
    SEAM(1);
    if (IN(2)) for (int rep_ = 0; rep_ < REPS(2); ++rep_) {
        for (int m = gw; m < MTOK; m += NGW) {
            const int t = m & (SEQ - 1);
            const bf16_t* prow = PRW + (size_t)m * PRW_LD; const bf16_t* qrow = PRW + (size_t)(t > 0 ? m - 1 : m) * PRW_LD;
            const float tm = t > 0 ? 1.f : 0.f;
            u32x4 lc = {0u, 0u, 0u, 0u}, lp = {0u, 0u, 0u, 0u};
            const int c8 = lane * 8;
            const u32x4 kc = *(const u32x4*)(prow + 512 + c8), kp_ = *(const u32x4*)(qrow + 512 + c8);
            if (lane < 36) { lc = *(const u32x4*)(prow + 1536 + 8 * lane); lp = *(const u32x4*)(qrow + 1536 + 8 * lane); }
            {
                float kc8[8], kp8[8]; unpack8(kc, kc8); unpack8(kp_, kp8);
                const f32x4 mk0 = *(const f32x4*)(a.in[4] + 512 + c8), mk1 = *(const f32x4*)(a.in[4] + 512 + c8 + 4), kk0 = *(const f32x4*)(a.in[10] + c8), kk1 = *(const f32x4*)(a.in[10] + c8 + 4);
                float ss = 0.f;
#pragma unroll
                for (int e = 0; e < 8; ++e) { const float muv = e < 4 ? mk0[e] : mk1[e - 4], kkv = e < 4 ? kk0[e] : kk1[e - 4]; const float kk = (kc8[e] + (kp8[e] * tm - kc8[e]) * muv) * kkv; ss += kk * kk; }
                ss = allsum8(ss);
                if ((lane & 7) == 0) RK[(size_t)m * 8 + (lane >> 3)] = rsqrtf(fmaxf(ss, 1e-24f)); }
            if (lane < 36) {
                const int c = 1536 + 8 * lane; float cur[8], prv[8]; unpack8(lc, cur); unpack8(lp, prv);
                const f32x4 mu0 = *(const f32x4*)(a.in[4] + c), mu1 = *(const f32x4*)(a.in[4] + c + 4); float o[8];
#pragma unroll
                for (int e = 0; e < 8; ++e) { const float muv = e < 4 ? mu0[e] : mu1[e - 4]; const float pm = cur[e] + (prv[e] * tm - cur[e]) * muv;
                    o[e] = (c < 1600) ? (1.0f - 2.0f * __builtin_amdgcn_rcpf(1.0f + __expf(2.0f * pm))) : ((c < 1664) ? pm : sigmoidf_(pm)); }
                *(u32x4*)(ALORA + (size_t)m * KLORA + 8 * lane) = pack8(o);
            } else if (lane < 48) *(u32x4*)(ALORA + (size_t)m * KLORA + 8 * lane) = (u32x4){0u, 0u, 0u, 0u};
        }
    }
    SEAM(2);
    if (IN(3)) for (int rep_ = 0; rep_ < REPS(3); ++rep_) {
        pg8::Gemm g{ALORA, WLORA, MTOK, NLORA, KLORA}; pg8::StaticOrder S; S.init(MTOK, NLORA, G, bx);
        EpiLora E{LW, GG, a.in[5], a.in[7]};
        pg8::gemm_phase<EpiLora, pg8::StaticOrder, true, true>(lds, g, S, E);
    }
    SEAM(3);
    if (IN(4)) {
#if (PROBE_MASK >> 14) & 1
        { int ds_ = 0; asm volatile("" : "+s"(ds_)); for (int u = gw; u < 3 * 4096; u += NGW) attn_unit(QKV, ALSE, u, lane, lds + wave * 4096, ds_); }
#endif
        for (int u = gw; u < 3 * 4096; u += NGW) attn_unit(QKV, ALSE, u, lane, lds + wave * 4096);
        __syncthreads();
        scan_block(a, lds, bx, tid);
        __syncthreads();
    }
    SEAM(4);
    if (IN(5)) for (int rep_ = 0; rep_ < REPS(5); ++rep_) {
        for (int m = gw; m < MTOK; m += NGW) {
            const int t = m & (SEQ - 1); const float tm = t > 0 ? 1.f : 0.f;
            const bf16_t* prow = PRW + (size_t)m * PRW_LD + 1024; const bf16_t* qrow = PRW + (size_t)(t > 0 ? m - 1 : m) * PRW_LD + 1024;
            const int c8 = lane * 8, hh = lane >> 3;
            const f32x4 y0 = *(const f32x4*)(YRAW + (size_t)m * 512 + c8), y1 = *(const f32x4*)(YRAW + (size_t)m * 512 + c8 + 4);
            const u32x4 cvw = *(const u32x4*)(prow + c8), pvw = *(const u32x4*)(qrow + c8), gqw = *(const u32x4*)(GG + (size_t)m * 512 + c8);
            const float rk = RSPB[(size_t)m * 8 + hh];
            u32x4 ao0 = {0u, 0u, 0u, 0u}, ao1 = ao0, ao2 = ao0; float l0 = 0.f, l1 = 0.f, l2 = 0.f;
            if (lane < 32) { const bf16_t* qp = QKV + (size_t)m * QKV_LD + c8; ao0 = *(const u32x4*)qp; ao1 = *(const u32x4*)(qp + 256); ao2 = *(const u32x4*)(qp + 512);
                l0 = ALSE[((size_t)0 * MTOK + m) * 4 + hh]; l1 = ALSE[((size_t)1 * MTOK + m) * 4 + hh]; l2 = ALSE[((size_t)2 * MTOK + m) * 4 + hh]; }
            const f32x4 lg0 = *(const f32x4*)(a.in[13] + c8), lg1 = *(const f32x4*)(a.in[13] + c8 + 4), lb0 = *(const f32x4*)(a.in[14] + c8), lb1 = *(const f32x4*)(a.in[14] + c8 + 4);
            const f32x4 mv0 = *(const f32x4*)(a.in[4] + 1024 + c8), mv1 = *(const f32x4*)(a.in[4] + 1024 + c8 + 4);
            float yv[8] = {y0[0], y0[1], y0[2], y0[3], y1[0], y1[1], y1[2], y1[3]}, cv8[8], pv8[8], gq8[8], o[8];
            unpack8(cvw, cv8); unpack8(pvw, pv8); unpack8(gqw, gq8);
            float sm = ((yv[0] + yv[1]) + (yv[2] + yv[3])) + ((yv[4] + yv[5]) + (yv[6] + yv[7])); sm = allsum8(sm);
            const float mean = sm * (1.0f / 64.0f); float sq = 0.f;
#pragma unroll
            for (int e = 0; e < 8; ++e) { yv[e] -= mean; sq += yv[e] * yv[e]; }
            sq = allsum8(sq); const float rstd = rsqrtf(sq * (1.0f / 64.0f) + 64e-5f);
#pragma unroll
            for (int e = 0; e < 8; ++e) { const float lg = e < 4 ? lg0[e] : lg1[e - 4], lb = e < 4 ? lb0[e] : lb1[e - 4], muv = e < 4 ? mv0[e] : mv1[e - 4];
                const float yn = yv[e] * rstd * lg + lb, vv = cv8[e] + (pv8[e] * tm - cv8[e]) * muv; o[e] = (yn + rk * vv) * gq8[e]; }
            *(u32x4*)(YA + (size_t)m * 512 + c8) = pack8(o);
            if (lane < 32) { float a0[8], a1[8], a2[8], ob[8]; unpack8(ao0, a0); unpack8(ao1, a1); unpack8(ao2, a2);
                const float mx = fmaxf(l0, fmaxf(l1, l2)), w0 = exp2f(l0 - mx), w1 = exp2f(l1 - mx), w2 = exp2f(l2 - mx), inv = 1.0f / (w0 + w1 + w2);
#pragma unroll
                for (int e = 0; e < 8; ++e) ob[e] = (w0 * a0[e] + w1 * a1[e] + w2 * a2[e]) * inv;
                *(u32x4*)(YB + (size_t)m * 256 + c8) = pack8(ob); }
        }
    }
    SEAM(5);
    if (IN(6)) for (int rep_ = 0; rep_ < REPS(6); ++rep_) {
        { pg8::Gemm g{YA, WA, MTOK, DM, 512}; pg8::StaticOrder S; S.init(MTOK, DM, G, bx); EpiBranch<0> E{MERGED, GATE};
          pg8::gemm_phase<EpiBranch<0>, pg8::StaticOrder, true, true>(lds, g, S, E); }
        __syncthreads();
        { pg8::Gemm g{YB, WB, MTOK, DM, 256}; pg8::StaticOrder S; S.init(MTOK, DM, G, bx); EpiBranch<1> E{MERGED, GATE};
          pg8::gemm_phase<EpiBranch<1>, pg8::StaticOrder, true, true>(lds, g, S, E); }
    }
    SEAM(6);
    if (IN(7)) for (int rep_ = 0; rep_ < REPS(7); ++rep_) {
        pg8::Gemm g{MERGED, WOUT, MTOK, DM, DM}; pg8::StaticOrder S; S.init(MTOK, DM, G, bx);
        EpiRes<0, false> E{a.in[0], nullptr, XB, RSPA, nullptr, nullptr};
        pg8::gemm_phase<EpiRes<0, false>, pg8::StaticOrder, true, true>(lds, g, S, E);
    }
    SEAM(7);
    if (IN(8)) for (int rep_ = 0; rep_ < REPS(8); ++rep_) {
        pg8::Gemm g{XB, WUP, MTOK, 6144, DM}; pg8::StaticOrder S; S.init(MTOK, 6144, G, bx);
        EpiUpGlu E{HMID, RSPA, a.in[22], a.in[23], (LAS float*)(lds + 131072 + 4096), (float*)(ws + OFF_UA), (float*)(ws + OFF_UB)};
        pg8::gemm_phase<EpiUpGlu, pg8::StaticOrder, true, true>(lds, g, S, E);
    }
    SEAM(8);
    if (IN(9)) {
        const float* UA = (const float*)(ws + OFF_UA); const float* UB = (const float*)(ws + OFF_UB);
        for (int it = gt; it < 128 * 24 * 16; it += NGT) {
            const int c8 = it & 15, pn = (it >> 4) % 24, pm = it / (24 * 16);
            const int tc = pn * 256 + c8 * 8, gc = pn * 128 + c8 * 8;
            const bool first = (pm & 15) == 0;
            float o0[8], o1[8];
#pragma unroll
            for (int hv = 0; hv < 2; ++hv) {
                const float* a0p = UA + ((size_t)pm * 2) * 6144 + tc + hv * 128; const float* b0p = UB + ((size_t)(first ? pm : pm - 1) * 2) * 6144 + tc + hv * 128; const int wc_ = gc + hv * 3072;
                float u0[8], u1[8], um2[8], um1[8], r0[8], r1[8];
#pragma unroll
                for (int e4 = 0; e4 < 2; ++e4) { const f32x4 x0 = *(const f32x4*)(a0p + 4 * e4), x1 = *(const f32x4*)(a0p + 6144 + 4 * e4), y0 = *(const f32x4*)(b0p + 4 * e4), y1 = *(const f32x4*)(b0p + 6144 + 4 * e4);
                    const f32x4 k0 = *(const f32x4*)(a.in[22] + wc_ + 4 * e4), k1 = *(const f32x4*)(a.in[22] + 6144 + wc_ + 4 * e4), k2 = *(const f32x4*)(a.in[22] + 2 * 6144 + wc_ + 4 * e4), kb = *(const f32x4*)(a.in[23] + wc_ + 4 * e4);
#pragma unroll
                    for (int e = 0; e < 4; ++e) { u0[4 * e4 + e] = x0[e]; u1[4 * e4 + e] = x1[e]; um2[4 * e4 + e] = first ? 0.f : y0[e]; um1[4 * e4 + e] = first ? 0.f : y1[e];
                        r0[4 * e4 + e] = kb[e] + k0[e] * x0[e] + k1[e] * um1[4 * e4 + e] + k2[e] * um2[4 * e4 + e];
                        r1[4 * e4 + e] = kb[e] + k0[e] * x1[e] + k1[e] * x0[e] + k2[e] * um1[4 * e4 + e]; } }
#pragma unroll
                for (int e = 0; e < 8; ++e) { if (hv == 0) { o0[e] = gelu_tanh(r0[e]); o1[e] = gelu_tanh(r1[e]); } else { o0[e] *= r0[e]; o1[e] *= r1[e]; } }
            }
            *(u32x4*)(HMID + ((size_t)pm * 256) * DFF + gc) = pack8(o0); *(u32x4*)(HMID + ((size_t)pm * 256 + 1) * DFF + gc) = pack8(o1);
        }
    }
    SEAM(9);
    if (IN(12)) {
        { pg8::Gemm g{HMID, WDN, MTOK, DM, DFF}; pg8::StaticOrder S; S.init(MTOK, DM, G, bx);
          EpiRes<0, true> E{nullptr, XB, XB, RSPB, nullptr, nullptr};
          pg8::gemm_phase<EpiRes<0, true>, pg8::StaticOrder, true, true>(lds, g, S, E); }
        __syncthreads();
        { pg8::Gemm g{PB, WPLE, MTOK, DM, 256}; pg8::StaticOrder S; S.init(MTOK, DM, G, bx); EpiPlain E{PL, DM};
          pg8::gemm_phase<EpiPlain, pg8::StaticOrder, true, true>(lds, g, S, E); }
    }
    SEAM(12);
    if (IN(13)) {
        pg8::Gemm g{XB, WPG, MTOK, DM, DM}; pg8::StaticOrder S; S.init(MTOK, DM, G, bx);
        EpiRes<1, true> E{nullptr, XB, HMID  , RSPA, RSPB, PL};
        pg8::gemm_phase<EpiRes<1, true>, pg8::StaticOrder, true, true>(lds, g, S, E);
    }
    SEAM(13);
    if (IN(14)) {
        for (int m0 = gw * 4; m0 < MTOK; m0 += NGW * 4) {
            u32x2 w[4][4]; float rs[4];
#pragma unroll
            for (int r = 0; r < 4; ++r) { const u32x2* xr = (const u32x2*)(HMID + (size_t)(m0 + r) * DM) + lane;
#pragma unroll
                for (int jj = 0; jj < 4; ++jj) w[r][jj] = xr[64 * jj];
                rs[r] = rstd16(RSPA, m0 + r); }
#pragma unroll
            for (int r = 0; r < 4; ++r) { f32x4* orow = (f32x4*)(a.out + (size_t)(m0 + r) * DM) + lane; const f32x4* gr = (const f32x4*)a.in[28] + lane;
#pragma unroll
                for (int jj = 0; jj < 4; ++jj) { const f32x4 gf = gr[64 * jj]; const f32x4 v = {bflo(w[r][jj].x), bfhi(w[r][jj].x), bflo(w[r][jj].y), bfhi(w[r][jj].y)}; __builtin_nontemporal_store(v * rs[r] * gf, orow + 64 * jj); } }
        }
    }
#undef IN
#undef SEAM
}

extern "C" void kernel_launch(void* const* d_in, const int* in_sizes, int n_in, void* d_out, int out_size, void* d_ws, size_t ws_size, hipStream_t stream) {
    static int grid = 0;
    if (grid == 0) {
        if (n_in != 29 || out_size != MTOK * DM || ws_size < WS_NEED) { fprintf(stderr, "kernel_launch: unexpected shapes (n_in %d out %d ws %zu need %zu)\n", n_in, out_size, ws_size, (size_t)WS_NEED); grid = -1; return; }
        int dev = 0, cus = 0, per_cu = 0;
        hipGetDevice(&dev); hipDeviceGetAttribute(&cus, hipDeviceAttributeMultiprocessorCount, dev);
        if (hipFuncSetAttribute((const void*)mk_fwd, hipFuncAttributeMaxDynamicSharedMemorySize, LDS_BYTES) != hipSuccess) { fprintf(stderr, "kernel_launch: hipFuncSetAttribute failed\n"); grid = -1; return; }
        if (hipOccupancyMaxActiveBlocksPerMultiprocessor(&per_cu, (const void*)mk_fwd, NWV * 64, LDS_BYTES) != hipSuccess || per_cu < 1) { fprintf(stderr, "kernel_launch: occupancy query says %d\n", per_cu); per_cu = 1; }
        (void)hipGetLastError();
        grid = cus * per_cu; if (grid > 256) grid = 256;
        if (grid < 256) fprintf(stderr, "kernel_launch: grid %d < 256\n", grid);
    }
    if (grid < 0) return;
    if (hipMemsetAsync((char*)d_ws + OFF_CTL, 0, CTL_BYTES, stream) != hipSuccess) { fprintf(stderr, "kernel_launch: memset failed\n"); return; }
    Args a{};
    for (int i = 0; i < 29; ++i) a.in[i] = (const float*)d_in[i];
    a.out = (float*)d_out; a.ws = (unsigned char*)d_ws;
#if MK_MULTI
    for (int ph = 0; ph < N_PHASES; ++ph) { a.ph_lo = ph; a.ph_hi = ph + 1; hipLaunchKernelGGL(mk_fwd, dim3(grid), dim3(NWV * 64), LDS_BYTES, stream, a); }
#else
    a.ph_lo = 0; a.ph_hi = N_PHASES;
    void* args[] = {&a};
    hipError_t e = hipLaunchCooperativeKernel((const void*)mk_fwd, dim3(grid), dim3(NWV * 64), args, LDS_BYTES, stream);
    if (e != hipSuccess) fprintf(stderr, "kernel_launch: cooperative launch failed: %s (grid %d)\n", hipGetErrorString(e), grid);
#endif
}
```

```cpp
#include <hip/hip_runtime.h>
#include <hip/hip_cooperative_groups.h>
#include <cstdio>
#include <cstdint>
namespace cg = cooperative_groups;
#ifndef MK_MULTI
#define MK_MULTI 0
#endif
namespace pg8 {
#define PG8_LAS __attribute__((address_space(3)))
typedef unsigned short bf16_t;
typedef short bf16x8 __attribute__((ext_vector_type(8)));
typedef float f32x4 __attribute__((ext_vector_type(4)));
typedef unsigned u32x4 __attribute__((ext_vector_type(4)));
constexpr int BM = 256, BK = 64, HALF = 128, HTB = HALF * BK * 2  , STAGE_BYTES = 8 * HTB, NXCD = 8, WGM = 8;

__host__ __device__ __forceinline__ int lds_byte(int r, int c) { const int st = (r >> 4) * 2 + (c >> 5), rr = r & 15, cc = c & 31, ob = rr * 64 + cc * 2; return st * 1024 + (ob ^ (((ob >> 9) & 1) << 5)); }
__host__ __device__ __forceinline__ void stage_rc(int b, int& R, int& C) { const int st = b / 1024, sb = b % 1024, swz = sb ^ (((sb >> 9) & 1) << 5); R = (st >> 1) * 16 + swz / 64; C = (st & 1) * 32 + (swz % 64) / 2; }
__host__ __device__ __forceinline__ int perm32(int rho) { const int n = rho >> 4, i = rho & 15; return 8 * (i >> 2) + 4 * n + (i & 3); }

struct Unit { int pm, pn; };
struct Gemm { const bf16_t* A; const bf16_t* Bt; int M, N, K; };
struct StaticOrder {
    int nM, nN, nwg, G, c;
    __host__ __device__ void init(int M, int N, int G_, int c_) { nM = M / BM; nN = N / BM; nwg = nM * nN; G = G_; c = c_; }
    __host__ __device__ bool next(int i, Unit& u) const {
        const long L = (long)i * G + c; if (L >= nwg) return false;
        int wgid = (int)L; { const int q = nwg / NXCD, r = nwg % NXCD, xcd = wgid % NXCD, off = wgid / NXCD; wgid = (xcd < r ? xcd * (q + 1) : r * (q + 1) + (xcd - r) * q) + off; }
        const int nig = WGM * nN, gid = wgid / nig, fm = gid * WGM, gsz = (nM - fm) < WGM ? (nM - fm) : WGM;
        u.pm = fm + ((wgid % nig) % gsz); u.pn = (wgid % nig) / gsz; return true;
    }
    __device__ __forceinline__ long arow(int pm) const { return (long)pm * BM; }
    __device__ __forceinline__ void a_ready(const Unit&) const {}
    __device__ __forceinline__ void done(const Unit&) const {}
};
__device__ __forceinline__ unsigned cvt_pk_bf16(float lo, float hi) { unsigned r; asm volatile("v_cvt_pk_bf16_f32 %0, %1, %2" : "=v"(r) : "v"(lo), "v"(hi)); return r; }
typedef float f32x2 __attribute__((ext_vector_type(2)));
template <class Epi, class Sched, bool ALIGN_EPI = false, bool SP2 = false>
__device__ __forceinline__ void gemm_phase(PG8_LAS unsigned char* lds, const Gemm g, const Sched& S, const Epi& E) {
    const int tid = threadIdx.x, wid = __builtin_amdgcn_readfirstlane(tid >> 6), lane = tid & 63, wr = wid >> 2, wc = wid & 3, fr = lane & 15, fq = lane >> 4;
    const int K = g.K, nt = K / BK;
    unsigned voffA[2], voffB[2];
#pragma unroll
    for (int i = 0; i < 2; ++i) { int R, C; stage_rc(tid * 16 + i * 8192, R, C); const int Rb = Epi::PERM ? ((R & ~31) + perm32(R & 31)) : R;
        voffA[i] = (unsigned)(R * K + C) * 2u; voffB[i] = (unsigned)(Rb * K + C) * 2u; }
    const size_t kstep = (size_t)(BK * 2);
    const size_t hstep = (size_t)HALF * K * 2;
    const size_t tstep = 2 * hstep;
    const unsigned ldsw = (unsigned)wid * 1024u;
    const int aoff = lds_byte(wr * 64 + fr, fq * 8), boff = lds_byte(wc * 32 + fr, fq * 8);
#define PG8_SA(b, h) (((b) * 2 + (h)) * HTB)
#define PG8_SB(b, h) ((4 + (b) * 2 + (h)) * HTB)
#define PG8_STAGE(bufoff, gbase, voff) do { _Pragma("unroll") for (int _i = 0; _i < 2; ++_i) \
        __builtin_amdgcn_global_load_lds((const unsigned*)((const char*)(gbase) + (voff)[_i]), (PG8_LAS unsigned*)(lds + (bufoff) + ldsw + _i * 8192), 16, 0, 0); } while (0)
#define PG8_LDA(dst, b, h) do { _Pragma("unroll") for (int m = 0; m < 4; ++m) _Pragma("unroll") for (int k = 0; k < 2; ++k) dst[m][k] = *(const PG8_LAS bf16x8*)(lds + PG8_SA(b, h) + aoff + m * 2048 + k * 1024); } while (0)
#define PG8_LDB(dst, b, h) do { _Pragma("unroll") for (int n = 0; n < 2; ++n) _Pragma("unroll") for (int k = 0; k < 2; ++k) dst[n][k] = *(const PG8_LAS bf16x8*)(lds + PG8_SB(b, h) + boff + n * 2048 + k * 1024); } while (0)
#define PG8_MMA(ai, bj, At, Bt) do { __builtin_amdgcn_s_setprio(1); _Pragma("unroll") for (int m = 0; m < 4; ++m) _Pragma("unroll") for (int n = 0; n < 2; ++n) _Pragma("unroll") for (int k = 0; k < 2; ++k) \
        acc[ai][bj][m][n] = __builtin_amdgcn_mfma_f32_16x16x32_bf16(Bt[n][k], At[m][k], acc[ai][bj][m][n], 0, 0, 0); __builtin_amdgcn_s_setprio(0); } while (0)
#define PG8_WAIT_V(n) asm volatile("s_waitcnt vmcnt(" #n ")" ::: "memory")
#define PG8_WAIT_L(n) asm volatile("s_waitcnt lgkmcnt(" #n ")" ::: "memory")
#define PG8_BAR __builtin_amdgcn_s_barrier()
#define PG8_SCHED __builtin_amdgcn_sched_barrier(0)
    Unit cur, nxt; int ui = 0;
    if (!S.next(0, cur)) return;
    f32x4 acc[2][2][4][2];
#pragma unroll
    for (int a = 0; a < 2; ++a)
#pragma unroll
        for (int b = 0; b < 2; ++b)
#pragma unroll
            for (int m = 0; m < 4; ++m)
#pragma unroll
                for (int n = 0; n < 2; ++n) acc[a][b][m][n] = (f32x4){0.f, 0.f, 0.f, 0.f};
    bf16x8 At[4][2], B0[2][2], B1[2][2];
    const char* cA = (const char*)g.A + (long)S.arow(cur.pm) * (long)(K * 2); const char* cB = (const char*)g.Bt + (size_t)cur.pn * tstep;
    S.a_ready(cur);
    if constexpr (SP2) {
        PG8_STAGE(PG8_SB(0, 0), cB, voffB); PG8_STAGE(PG8_SB(0, 1), cB + hstep, voffB); PG8_STAGE(PG8_SA(0, 0), cA, voffA); PG8_STAGE(PG8_SA(0, 1), cA + hstep, voffA);
        if (wr == 1) PG8_BAR;
        PG8_WAIT_V(2); PG8_BAR;
        PG8_STAGE(PG8_SB(1, 0), cB + kstep, voffB); PG8_STAGE(PG8_SA(1, 0), cA + kstep, voffA); PG8_STAGE(PG8_SB(1, 1), cB + hstep + kstep, voffB);
        PG8_WAIT_V(6); PG8_BAR;
    } else {
        PG8_STAGE(PG8_SB(0, 0), cB, voffB); PG8_STAGE(PG8_SA(0, 0), cA, voffA); PG8_STAGE(PG8_SB(0, 1), cB + hstep, voffB); PG8_STAGE(PG8_SA(0, 1), cA + hstep, voffA);
        if (wr == 1) PG8_BAR;
        PG8_WAIT_V(4); PG8_BAR;
        PG8_STAGE(PG8_SB(1, 0), cB + kstep, voffB); PG8_STAGE(PG8_SA(1, 0), cA + kstep, voffA); PG8_STAGE(PG8_SB(1, 1), cB + hstep + kstep, voffB);
        PG8_WAIT_V(6); PG8_BAR;
    }
    for (;;) {
        const bool has_next = S.next(ui + 1, nxt);
        const char* nA = has_next ? (const char*)g.A + (long)S.arow(nxt.pm) * (long)(K * 2) : cA; const char* nB = has_next ? (const char*)g.Bt + (size_t)nxt.pn * tstep : cB;
#pragma unroll 1
        for (int t = 0; t < nt; t += 2) {
            const bool last = (t == nt - 2);
            const char* a1 = cA + (size_t)(t + 1) * kstep;
            const char* a2 = last ? nA : cA + (size_t)(t + 2) * kstep; const char* b2 = last ? nB : cB + (size_t)(t + 2) * kstep;
            const char* a3 = a2 + kstep; const char* b3 = b2 + kstep;
            if (last && has_next) S.a_ready(nxt);
            if constexpr (SP2) {
            PG8_LDB(B0, 0, 0); PG8_LDB(B1, 0, 1); PG8_SCHED; PG8_LDA(At, 0, 0); PG8_STAGE(PG8_SA(1, 1), a1 + hstep, voffA);
            PG8_WAIT_V(8); PG8_WAIT_L(0); PG8_BAR; PG8_MMA(0, 0, At, B0); PG8_MMA(0, 1, At, B1); PG8_BAR; PG8_SCHED;
            PG8_LDA(At, 0, 1); PG8_STAGE(PG8_SB(0, 0), b2, voffB); PG8_STAGE(PG8_SB(0, 1), b2 + hstep, voffB); PG8_STAGE(PG8_SA(0, 0), a2, voffA);
            PG8_WAIT_V(8); PG8_WAIT_L(0); PG8_BAR; PG8_MMA(1, 0, At, B0); PG8_MMA(1, 1, At, B1); PG8_BAR; PG8_SCHED;
            PG8_LDB(B0, 1, 0); PG8_LDB(B1, 1, 1); PG8_SCHED; PG8_LDA(At, 1, 0); PG8_STAGE(PG8_SA(0, 1), a2 + hstep, voffA);
            PG8_WAIT_V(8); PG8_WAIT_L(0); PG8_BAR; PG8_MMA(0, 0, At, B0); PG8_MMA(0, 1, At, B1); PG8_BAR; PG8_SCHED;
            PG8_LDA(At, 1, 1); PG8_STAGE(PG8_SB(1, 0), b3, voffB); PG8_STAGE(PG8_SB(1, 1), b3 + hstep, voffB); PG8_STAGE(PG8_SA(1, 0), a3, voffA);
            PG8_WAIT_V(8); PG8_WAIT_L(0); PG8_BAR; PG8_MMA(1, 0, At, B0); PG8_MMA(1, 1, At, B1); PG8_BAR; PG8_SCHED;
            } else {
            PG8_LDB(B0, 0, 0); PG8_SCHED; PG8_LDA(At, 0, 0); PG8_STAGE(PG8_SA(1, 1), a1 + hstep, voffA);
            PG8_WAIT_L(8); PG8_BAR; PG8_WAIT_L(0); PG8_MMA(0, 0, At, B0); PG8_BAR; PG8_SCHED;
            PG8_LDB(B1, 0, 1); PG8_STAGE(PG8_SB(0, 0), b2, voffB);
            PG8_BAR; PG8_WAIT_L(0); PG8_MMA(0, 1, At, B1); PG8_BAR;
            PG8_LDA(At, 0, 1); PG8_STAGE(PG8_SA(0, 0), a2, voffA);
            PG8_BAR; PG8_WAIT_L(0); PG8_MMA(1, 0, At, B0); PG8_BAR; PG8_SCHED;
            PG8_STAGE(PG8_SB(0, 1), b2 + hstep, voffB);
            PG8_WAIT_V(6); PG8_BAR; PG8_MMA(1, 1, At, B1); PG8_BAR;
            PG8_LDB(B0, 1, 0); PG8_SCHED; PG8_LDA(At, 1, 0); PG8_STAGE(PG8_SA(0, 1), a2 + hstep, voffA);
            PG8_WAIT_L(8); PG8_BAR; PG8_WAIT_L(0); PG8_MMA(0, 0, At, B0); PG8_BAR; PG8_SCHED;
            PG8_LDB(B1, 1, 1); PG8_STAGE(PG8_SB(1, 0), b3, voffB);
            PG8_BAR; PG8_WAIT_L(0); PG8_MMA(0, 1, At, B1); PG8_BAR;
            PG8_LDA(At, 1, 1); PG8_STAGE(PG8_SA(1, 0), a3, voffA);
            PG8_BAR; PG8_WAIT_L(0); PG8_MMA(1, 0, At, B0); PG8_BAR; PG8_SCHED;
            PG8_STAGE(PG8_SB(1, 1), b3 + hstep, voffB);
            PG8_WAIT_V(6); PG8_BAR; PG8_MMA(1, 1, At, B1); PG8_BAR;
            }
        }
        if constexpr (ALIGN_EPI) { if (wr == 0) PG8_BAR; }
        if constexpr (!Epi::AFTER_DRAIN) { E(acc, cur, wr, wc, fr, fq); S.done(cur); }
        if (!has_next) break;
#pragma unroll
        for (int a = 0; a < 2; ++a)
#pragma unroll
            for (int b = 0; b < 2; ++b)
#pragma unroll
                for (int m = 0; m < 4; ++m)
#pragma unroll
                    for (int n = 0; n < 2; ++n) acc[a][b][m][n] = (f32x4){0.f, 0.f, 0.f, 0.f};
        cur = nxt; cA = nA; cB = nB; ++ui;
        if constexpr (ALIGN_EPI) { if (wr == 1) PG8_BAR; }
    }
    PG8_WAIT_V(0);
    if constexpr (!ALIGN_EPI) { if (wr == 0) PG8_BAR; }
    PG8_BAR;
    if constexpr (Epi::AFTER_DRAIN) { E.fused(acc, cur, wr, wc, fr, fq, lds, wid, lane); S.done(cur); }
#undef PG8_SA
#undef PG8_SB
#undef PG8_STAGE
#undef PG8_LDA
#undef PG8_LDB
#undef PG8_MMA
#undef PG8_WAIT_V
#undef PG8_WAIT_L
#undef PG8_BAR
#undef PG8_SCHED
}
}

constexpr int NWV = 8;
constexpr int BATCH = 8, SEQ = 4096, DM = 1024, MTOK = BATCH * SEQ;
constexpr int PRW_LD = 2048, QKV_LD = 2304, N1 = 6400;
constexpr int RWC = 1824, KLORA = 384, NLORA = 1536, DFF = 3072;
constexpr float NEPS = 1e-6f;
constexpr float LOG2E = 1.4426950408889634f;
constexpr size_t HM = 512 * 1024;
constexpr size_t OFF_W1T = 0, OFF_WLORA = 25 * HM, OFF_WA = 28 * HM, OFF_WB = 30 * HM, OFF_WOUT = 31 * HM, OFF_WUP = 35 * HM, OFF_WDN = 59 * HM, OFF_WPG = 71 * HM, OFF_WPLE = 75 * HM;
constexpr size_t OFF_RS0 = 76 * HM, OFF_RSPA = 77 * HM, OFF_RSPB = 81 * HM, OFF_RK = 85 * HM, OFF_ALSE = 87 * HM, OFF_PB = 90 * HM, OFF_XB = 122 * HM, OFF_BIG = 250 * HM;
constexpr size_t OFF_PRW = OFF_BIG, OFF_QKV = 506 * HM, OFF_LW = 794 * HM, OFF_AA = 858 * HM, OFF_GG = 922 * HM;
constexpr size_t OFF_ALORA = OFF_XB, OFF_YRAW = OFF_XB, OFF_YA = OFF_LW, OFF_YB = OFF_AA, OFF_MERGED = OFF_PRW, OFF_U = OFF_BIG, OFF_HMID = 634 * HM, OFF_PL = OFF_BIG;
constexpr size_t OFF_UA = 378 * HM, OFF_UB = 392 * HM;
constexpr size_t OFF_CTL = 1018 * HM, CTL_BYTES = 65536;
constexpr size_t WS_NEED = OFF_CTL + CTL_BYTES;
constexpr int LDS_BYTES = 147456;
constexpr int N_PHASES = 15;
constexpr int SCAN_BLOCKS = 128;

#define LAS __attribute__((address_space(3)))
typedef unsigned short bf16_t;
typedef float f32x4 __attribute__((ext_vector_type(4)));
typedef unsigned u32x4 __attribute__((ext_vector_type(4)));
typedef unsigned u32x2 __attribute__((ext_vector_type(2)));
typedef short bf16x8 __attribute__((ext_vector_type(8)));
typedef float f32x16 __attribute__((ext_vector_type(16)));
#define LDS_WAIT() asm volatile("s_waitcnt lgkmcnt(0)" ::: "memory")

__device__ __forceinline__ float bf2f(unsigned h) { return __uint_as_float(h << 16); }
__device__ __forceinline__ float bflo(unsigned w) { return __uint_as_float(w << 16); }
__device__ __forceinline__ float bfhi(unsigned w) { return __uint_as_float(w & 0xffff0000u); }
__device__ __forceinline__ unsigned f2bf(float f) { unsigned u = __float_as_uint(f); return (u + 0x7fffu + ((u >> 16) & 1u)) >> 16; }
__device__ __forceinline__ unsigned pk2(float lo, float hi) { return f2bf(lo) | (f2bf(hi) << 16); }
__device__ __forceinline__ float sigmoidf_(float x) { return __builtin_amdgcn_rcpf(1.0f + __expf(-x)); }
__device__ __forceinline__ float dpp_add(float x, const int ctrl_sel) {
    int t;
    if (ctrl_sel == 0) t = __builtin_amdgcn_update_dpp(0, __float_as_int(x), 0xB1, 0xf, 0xf, true);
    else if (ctrl_sel == 1) t = __builtin_amdgcn_update_dpp(0, __float_as_int(x), 0x4E, 0xf, 0xf, true);
    else if (ctrl_sel == 2) t = __builtin_amdgcn_update_dpp(0, __float_as_int(x), 0x141, 0xf, 0xf, true);
    else t = __builtin_amdgcn_update_dpp(0, __float_as_int(x), 0x140, 0xf, 0xf, true);
    return x + __int_as_float(t);
}
__device__ __forceinline__ float allsum16(float x) { x = dpp_add(x, 0); x = dpp_add(x, 1); x = dpp_add(x, 2); x = dpp_add(x, 3); return x; }
__device__ __forceinline__ float allsum8(float x) { x = dpp_add(x, 0); x = dpp_add(x, 1); x = dpp_add(x, 2); return x; }
__device__ __forceinline__ float wave_sum(float v) {
    v = allsum16(v);
    const float s0 = __int_as_float(__builtin_amdgcn_readlane(__float_as_int(v), 0)), s1 = __int_as_float(__builtin_amdgcn_readlane(__float_as_int(v), 16));
    const float s2 = __int_as_float(__builtin_amdgcn_readlane(__float_as_int(v), 32)), s3 = __int_as_float(__builtin_amdgcn_readlane(__float_as_int(v), 48));
    return (s0 + s1) + (s2 + s3);
}
__device__ __forceinline__ void unpack8(const u32x4 w, float (&f)[8]) { f[0] = bflo(w.x); f[1] = bfhi(w.x); f[2] = bflo(w.y); f[3] = bfhi(w.y); f[4] = bflo(w.z); f[5] = bfhi(w.z); f[6] = bflo(w.w); f[7] = bfhi(w.w); }
__device__ __forceinline__ u32x4 pack8(const float (&f)[8]) { u32x4 w; w.x = pk2(f[0], f[1]); w.y = pk2(f[2], f[3]); w.z = pk2(f[4], f[5]); w.w = pk2(f[6], f[7]); return w; }

__device__ __forceinline__ float gelu_tanh(float x) { const float z = x * (-2.3022082f + (-0.1029432f) * (x * x)); return x * __builtin_amdgcn_rcpf(1.0f + __builtin_amdgcn_exp2f(z)); }
struct Args { const float* in[29]; float* out; unsigned char* ws; int ph_lo, ph_hi; };

#define EPI_ROWS(...) _Pragma("unroll") for (int ai = 0; ai < 2; ++ai) _Pragma("unroll") for (int m = 0; m < 4; ++m) { const int row = row0 + ai * 128 + m * 16; __VA_ARGS__ asm volatile("" ::: "memory"); }
typedef float f32x2c_t __attribute__((ext_vector_type(2))); typedef __bf16 bf16x2c_t __attribute__((ext_vector_type(2)));
__device__ __forceinline__ unsigned cvtpk_c(float lo, float hi) { const f32x2c_t v = {lo, hi}; const bf16x2c_t b = __builtin_convertvector(v, bf16x2c_t); return __builtin_bit_cast(unsigned, b); }
__device__ __forceinline__ u32x4 pack_acc8(const f32x4 v0, const f32x4 v1) { u32x4 w; w.x = cvtpk_c(v0[0], v0[1]); w.y = cvtpk_c(v0[2], v0[3]); w.z = cvtpk_c(v1[0], v1[1]); w.w = cvtpk_c(v1[2], v1[3]); return w; }
__device__ __forceinline__ float rstd16(const float* rsp, int row) {
    const f32x4* p = (const f32x4*)(rsp + (size_t)row * 16); const f32x4 a = p[0], b = p[1], c = p[2], d = p[3];
    const float s = (((a[0] + a[1]) + (a[2] + a[3])) + ((b[0] + b[1]) + (b[2] + b[3]))) + (((c[0] + c[1]) + (c[2] + c[3])) + ((d[0] + d[1]) + (d[2] + d[3])));
    return rsqrtf(s * (1.0f / DM) + NEPS);
}

struct EpiG1 {
    static constexpr bool PERM = true, AFTER_DRAIN = false;
    bf16_t* prw; bf16_t* qkv; bf16_t* gate; const float* rs0; const float* bg;
    __device__ __forceinline__ void operator()(const f32x4 (&acc)[2][2][4][2], const pg8::Unit& u, int wr, int wc, int fr, int fq) const {
        const int row0 = u.pm * 256 + wr * 64 + fr, ct = wc * 32 + 8 * fq;
        bf16_t* base; int ld, coff; const bool isg = u.pn >= 17;
        if (u.pn < 8) { base = prw; ld = PRW_LD; coff = u.pn * 256; } else if (u.pn < 17) { base = qkv; ld = QKV_LD; coff = (u.pn - 8) * 256; } else { base = gate; ld = 2048; coff = (u.pn - 17) * 256; }
        f32x4 bv[2][2];
#pragma unroll
        for (int bj = 0; bj < 2; ++bj)
#pragma unroll
            for (int n = 0; n < 2; ++n) bv[bj][n] = isg ? *(const f32x4*)(bg + coff + ct + bj * 128 + 4 * n) : (f32x4){0.f, 0.f, 0.f, 0.f};
        EPI_ROWS(
            const float rs = rs0[row]; bf16_t* rp = base + (size_t)row * ld + coff + ct;
            _Pragma("unroll") for (int bj = 0; bj < 2; ++bj) { f32x4 v0 = acc[ai][bj][m][0] * rs, v1 = acc[ai][bj][m][1] * rs;
                if (isg) { v0 = v0 + bv[bj][0]; v1 = v1 + bv[bj][1];
                    _Pragma("unroll") for (int e = 0; e < 4; ++e) { v0[e] = sigmoidf_(v0[e]); v1[e] = sigmoidf_(v1[e]); } }
                __builtin_nontemporal_store(pack_acc8(v0, v1), (u32x4*)(rp + bj * 128)); }
        )
    }
};
__device__ __forceinline__ float lwf(float x) { const float z = -x; const float sp = fmaxf(z, 0.f) + __logf(1.0f + __expf(-fabsf(z))); return -__expf(-sp - 0.5f); }
struct EpiLora {
    static constexpr bool PERM = true, AFTER_DRAIN = false;
    bf16_t* lw; bf16_t* gg; const float* w0; const float* a0;
    __device__ __forceinline__ void operator()(const f32x4 (&acc)[2][2][4][2], const pg8::Unit& u, int wr, int wc, int fr, int fq) const {
        const int row0 = u.pm * 256 + wr * 64 + fr, ct = wc * 32 + 8 * fq; const bool first = u.pn < 4;
        bf16_t* base = (first ? lw + u.pn * 256 : gg + (u.pn - 4) * 256) + ct; const int ld = first ? 1024 : 512;
        const float* bsrc = (u.pn < 2 ? w0 + u.pn * 256 : a0 + (u.pn & 1) * 256) + ct;
        f32x4 bv[2][2];
#pragma unroll
        for (int bj = 0; bj < 2; ++bj)
#pragma unroll
            for (int n = 0; n < 2; ++n) bv[bj][n] = first ? *(const f32x4*)(bsrc + bj * 128 + 4 * n) : (f32x4){0.f, 0.f, 0.f, 0.f};
        EPI_ROWS(
            bf16_t* rp = base + (size_t)row * ld;
            _Pragma("unroll") for (int bj = 0; bj < 2; ++bj) { f32x4 v0 = acc[ai][bj][m][0], v1 = acc[ai][bj][m][1];
                if (first) { v0 = v0 + bv[bj][0]; v1 = v1 + bv[bj][1];
                    _Pragma("unroll") for (int e = 0; e < 4; ++e) { v0[e] = sigmoidf_(v0[e]); v1[e] = sigmoidf_(v1[e]); } }
                *(u32x4*)(rp + bj * 128) = pack_acc8(v0, v1); }
        )
    }
};
template <int WHICH> struct EpiBranch {
    static constexpr bool PERM = true, AFTER_DRAIN = false;
    bf16_t* merged; const bf16_t* gate;
    __device__ __forceinline__ void operator()(const f32x4 (&acc)[2][2][4][2], const pg8::Unit& u, int wr, int wc, int fr, int fq) const {
        const int row0 = u.pm * 256 + wr * 64 + fr, ct = u.pn * 256 + wc * 32 + 8 * fq;
        EPI_ROWS(
            bf16_t* rp = merged + (size_t)row * DM + ct; const bf16_t* gp = gate + (size_t)row * 2048 + WHICH * 1024 + ct;
            _Pragma("unroll") for (int bj = 0; bj < 2; ++bj) { float gv[8]; unpack8(*(const u32x4*)(gp + bj * 128), gv);
                f32x4 v0 = acc[ai][bj][m][0], v1 = acc[ai][bj][m][1];
                _Pragma("unroll") for (int e = 0; e < 4; ++e) { v0[e] *= gv[e]; v1[e] *= gv[4 + e]; }
                if (WHICH == 1) { float tv[8]; unpack8(*(const u32x4*)(rp + bj * 128), tv);
                    _Pragma("unroll") for (int e = 0; e < 4; ++e) { v0[e] += tv[e]; v1[e] += tv[4 + e]; } }
                *(u32x4*)(rp + bj * 128) = pack_acc8(v0, v1); }
        )
    }
};
template <int MODE, bool RES_BF16> struct EpiRes {
    static constexpr bool PERM = true, AFTER_DRAIN = false;
    const float* res; const bf16_t* resb; bf16_t* xb; float* rsp_out; const float* rsp_in; const bf16_t* pl;
    __device__ __forceinline__ void operator()(const f32x4 (&acc)[2][2][4][2], const pg8::Unit& u, int wr, int wc, int fr, int fq) const {
        const int row0 = u.pm * 256 + wr * 64 + fr, ct = u.pn * 256 + wc * 32 + 8 * fq;
        EPI_ROWS(
            const size_t ro = (size_t)row * DM + ct; float q = 0.f; float rs = 1.f; if (MODE == 1) rs = rstd16(rsp_in, row);
            _Pragma("unroll") for (int bj = 0; bj < 2; ++bj) { f32x4 v0 = acc[ai][bj][m][0], v1 = acc[ai][bj][m][1];
                if (MODE == 1) { float pv[8]; unpack8(*(const u32x4*)(pl + ro + bj * 128), pv);
                    _Pragma("unroll") for (int e = 0; e < 4; ++e) { v0[e] = sigmoidf_(v0[e] * rs) * pv[e]; v1[e] = sigmoidf_(v1[e] * rs) * pv[4 + e]; } }
                if (RES_BF16) { float rv[8]; unpack8(*(const u32x4*)(resb + ro + bj * 128), rv);
                    _Pragma("unroll") for (int e = 0; e < 4; ++e) { v0[e] += rv[e]; v1[e] += rv[4 + e]; } }
                else { const f32x4 r0 = *(const f32x4*)(res + ro + bj * 128), r1 = *(const f32x4*)(res + ro + bj * 128 + 4); v0 = v0 + r0; v1 = v1 + r1; }
                *(u32x4*)(xb + ro + bj * 128) = pack_acc8(v0, v1);
                q += ((v0[0] * v0[0] + v0[1] * v0[1]) + (v0[2] * v0[2] + v0[3] * v0[3])) + ((v1[0] * v1[0] + v1[1] * v1[1]) + (v1[2] * v1[2] + v1[3] * v1[3])); }
            q += __shfl_xor(q, 16); q += __shfl_xor(q, 32);
            if (fq == 0) rsp_out[(size_t)row * 16 + u.pn * 4 + wc] = q;
        )
    }
};
struct EpiUp {
    static constexpr bool PERM = true, AFTER_DRAIN = false;
    bf16_t* U; const float* rsp; int rowbase;
    __device__ __forceinline__ void operator()(const f32x4 (&acc)[2][2][4][2], const pg8::Unit& u, int wr, int wc, int fr, int fq) const {
        const int row0 = u.pm * 256 + wr * 64 + fr, ct = u.pn * 256 + wc * 32 + 8 * fq;
        EPI_ROWS(
            const float rs = rstd16(rsp, rowbase + row); bf16_t* rp = U + (size_t)row * 6144 + ct;
            _Pragma("unroll") for (int bj = 0; bj < 2; ++bj) *(u32x4*)(rp + bj * 128) = pack_acc8(acc[ai][bj][m][0] * rs, acc[ai][bj][m][1] * rs);
        )
    }
};
struct UpOrder : pg8::StaticOrder {
    __device__ __forceinline__ long arow(int pm) const { return (long)(pm / 17) * SEQ + 254 * (pm % 17) - 2; }
};
template <int CTRL> __device__ __forceinline__ float dppf(float x) { return __int_as_float(__builtin_amdgcn_update_dpp(0, __float_as_int(x), CTRL, 0xf, 0xf, true)); }
struct EpiUpGlu {
    static constexpr bool PERM = true, AFTER_DRAIN = false;
    bf16_t* hmid; const float* rsp; const float* cw; const float* cb; LAS float* xch; float* ua; float* ub;
    __device__ __forceinline__ void operator()(f32x4 (&acc)[2][2][4][2], const pg8::Unit& u, int wr, int wc, int fr, int fq) const {
        const int rowt = u.pm * 256;
        const int rho0 = wr * 64 + fr, ct = wc * 32 + 8 * fq;
#pragma unroll
        for (int ai = 0; ai < 2; ++ai)
#pragma unroll
            for (int m = 0; m < 4; ++m) { const float rs = rstd16(rsp, rowt + rho0 + ai * 128 + m * 16);
#pragma unroll
                for (int bj = 0; bj < 2; ++bj) { acc[ai][bj][m][0] = acc[ai][bj][m][0] * rs; acc[ai][bj][m][1] = acc[ai][bj][m][1] * rs; }
                asm volatile("" : "+v"(acc[ai][0][m][0]), "+v"(acc[ai][0][m][1]), "+v"(acc[ai][1][m][0]), "+v"(acc[ai][1][m][1]) :: "memory"); __builtin_amdgcn_sched_barrier(0); }
        if (fr >= 14) {
#pragma unroll
            for (int ai = 0; ai < 2; ++ai)
#pragma unroll
                for (int bj = 0; bj < 2; ++bj)
#pragma unroll
                    for (int n = 0; n < 2; ++n) *(LAS f32x4*)(xch + ((ai * 2 + wr) * 2 + (fr - 14)) * 256 + bj * 128 + ct + 4 * n) = acc[ai][bj][3][n];
            if (wr == 1) {
                float* ubp = ub + ((size_t)u.pm * 2 + (fr - 14)) * 6144 + u.pn * 256 + ct;
                *(f32x4*)(ubp) = acc[1][0][3][0]; *(f32x4*)(ubp + 4) = acc[1][0][3][1]; *(f32x4*)(ubp + 128) = acc[1][1][3][0]; *(f32x4*)(ubp + 132) = acc[1][1][3][1];
            }
        }
        if (wr == 0 && fr < 2) {
            float* uap = ua + ((size_t)u.pm * 2 + fr) * 6144 + u.pn * 256 + ct;
            *(f32x4*)(uap) = acc[0][0][0][0]; *(f32x4*)(uap + 4) = acc[0][0][0][1]; *(f32x4*)(uap + 128) = acc[0][1][0][0]; *(f32x4*)(uap + 132) = acc[0][1][0][1];
        }
        __builtin_amdgcn_sched_barrier(0);
        asm volatile("s_waitcnt lgkmcnt(0)" ::: "memory"); __builtin_amdgcn_s_barrier(); asm volatile("" ::: "memory");
        const float m1 = (fr == 0) ? 1.f : 0.f, m2 = (fr < 2) ? 1.f : 0.f;
#pragma unroll
        for (int n = 0; n < 2; ++n) {
#pragma unroll
            for (int bj = 0; bj < 2; ++bj) {
                const int col = bj * 3072 + u.pn * 128 + ct + 4 * n;
                const f32x4 c0 = *(const f32x4*)(cw + col), c1 = *(const f32x4*)(cw + 6144 + col), c2 = *(const f32x4*)(cw + 2 * 6144 + col), cbv = *(const f32x4*)(cb + col);
                const f32x4 c1m = c1 * m1, c2m = c2 * m2;
#pragma unroll
                for (int ai = 0; ai < 2; ++ai) {
                    const int seg = ai * 2 + wr;
                    f32x4 X = {0.f, 0.f, 0.f, 0.f};
                    if (seg > 0) X = *(const LAS f32x4*)(xch + ((seg - 1) * 2 + (fr & 1)) * 256 + bj * 128 + ct + 4 * n);
#pragma unroll
                    for (int m = 3; m >= 0; --m) {
                        f32x4 v = acc[ai][bj][m][n]; f32x4 vp = (m > 0) ? acc[ai][bj][m > 0 ? m - 1 : 0][n] : X; f32x4 o;
                        asm volatile("" : "+v"(v), "+v"(vp));
#pragma unroll
                        for (int e = 0; e < 4; ++e) {
                            float r = cbv[e] + c0[e] * v[e];
                            r += c1[e] * dppf<0x111>(v[e]); r += c1m[e] * dppf<0x121>(vp[e]);
                            r += c2[e] * dppf<0x112>(v[e]); r += c2m[e] * dppf<0x122>(vp[e]);
                            o[e] = r; }
                        asm volatile("" : "+v"(o));
                        acc[ai][bj][m][n] = o;
                        __builtin_amdgcn_sched_barrier(0);
                    }
                }
            }
#pragma unroll
            for (int ai = 0; ai < 2; ++ai)
#pragma unroll
                for (int m = 0; m < 4; ++m) { f32x4 gv = acc[ai][0][m][n]; const f32x4 vv = acc[ai][1][m][n];
#pragma unroll
                    for (int e = 0; e < 4; ++e) gv[e] = gelu_tanh(gv[e]) * vv[e];
                    asm volatile("" : "+v"(gv));
                    acc[ai][0][m][n] = gv; __builtin_amdgcn_sched_barrier(0); }
        }
#pragma unroll
        for (int ai = 0; ai < 2; ++ai)
#pragma unroll
            for (int m = 0; m < 4; ++m) { const int rho = rho0 + ai * 128 + m * 16;
                if (rho >= 2) __builtin_nontemporal_store(pack_acc8(acc[ai][0][m][0], acc[ai][0][m][1]), (u32x4*)(hmid + ((size_t)rowt + rho) * DFF + u.pn * 128 + ct));
                asm volatile("" ::: "memory"); __builtin_amdgcn_sched_barrier(0); }
    }
};
struct EpiPlain {
    static constexpr bool PERM = true, AFTER_DRAIN = false;
    bf16_t* O; int ld;
    __device__ __forceinline__ void operator()(const f32x4 (&acc)[2][2][4][2], const pg8::Unit& u, int wr, int wc, int fr, int fq) const {
        const int row0 = u.pm * 256 + wr * 64 + fr, ct = u.pn * 256 + wc * 32 + 8 * fq;
        EPI_ROWS(
            bf16_t* rp = O + (size_t)row * ld + ct;
            _Pragma("unroll") for (int bj = 0; bj < 2; ++bj) *(u32x4*)(rp + bj * 128) = pack_acc8(acc[ai][bj][m][0], acc[ai][bj][m][1]);
        )
    }
};

__device__ __forceinline__ void tr_item(const float* __restrict__ W, int ldw, int k0, int n0, const float* __restrict__ g, bf16_t* WT, int ldd, int drow0, LAS float* scr, int lane) {
    f32x4 wv[8];
#pragma unroll
    for (int i = 0; i < 8; ++i) wv[i] = __builtin_nontemporal_load((const f32x4*)(W + (size_t)(k0 + 8 * i + (lane >> 3)) * ldw + n0 + 4 * (lane & 7)));
#pragma unroll
    for (int i = 0; i < 8; ++i) { const int kk = 8 * i + (lane >> 3); f32x4 v = wv[i]; if (g) v = v * g[k0 + kk];
        LAS float* sp = scr + kk * 33 + 4 * (lane & 7); sp[0] = v[0]; sp[1] = v[1]; sp[2] = v[2]; sp[3] = v[3]; }
    LDS_WAIT();
    const int c = lane & 7;
#pragma unroll
    for (int j = 0; j < 4; ++j) { const int n = (lane >> 3) + 8 * j; const LAS float* s = scr + (8 * c) * 33 + n;
        u32x4 o; o.x = pk2(s[0 * 33], s[1 * 33]); o.y = pk2(s[2 * 33], s[3 * 33]); o.z = pk2(s[4 * 33], s[5 * 33]); o.w = pk2(s[6 * 33], s[7 * 33]);
        *(u32x4*)(WT + (size_t)(drow0 + n) * ldd + k0 + 8 * c) = o; }
    LDS_WAIT();
}
__device__ __forceinline__ void tr_matrix_item(const float* W, int K, int N, const float* g, bf16_t* WT, int r, LAS float* scr, int lane) {
    const int nblk = N / 32, kb = r / nblk, nb = r % nblk; tr_item(W, N, 64 * kb, 32 * nb, g, WT, K, 32 * nb, scr, lane);
}

__device__ __forceinline__ int crow(int r, int hi) { return (r & 3) + 8 * (r >> 2) + 4 * hi; }
typedef short v4i16_t __attribute__((ext_vector_type(4)));
__device__ __forceinline__ void attn_unit(bf16_t* QKV, float* ALSE, int unit, int lane, LAS unsigned char* vlds  , int do_store = 1) {
    const int g = unit >> 12, rem = unit & 4095, b = rem >> 9, hg = (rem >> 7) & 3, tile = rem & 127;
    const int d = (g == 0) ? 1 : ((g == 1) ? 4 : 16), tps = 128 / d, r = tile / tps, qt = tile % tps, i0 = 32 * qt;
    const int h = g * 4 + hg;
    const float slope = exp2f(-8.0f * (float)(h + 1) / 12.0f);
    const float c1 = 0.125f * LOG2E, c2 = slope * (float)d * LOG2E;
    const int qq = lane & 31, hi = lane >> 5;
    const size_t rowq = (size_t)b * SEQ + r + (size_t)d * (i0 + qq);
    bf16_t* qptr = QKV + rowq * QKV_LD + h * 64;
    bf16x8 qf[4];
#pragma unroll
    for (int ds = 0; ds < 4; ++ds) qf[ds] = *(const bf16x8*)(qptr + 16 * ds + 8 * hi);
    const bf16_t* Kb = QKV + ((size_t)b * SEQ + r) * QKV_LD + 768 + h * 64;
    const bf16_t* Vb = QKV + ((size_t)b * SEQ + r) * QKV_LD + 1536 + h * 64;
    float m_run = -1e30f, l_run = 0.f;
    f32x16 o0, o1;
#pragma unroll
    for (int i = 0; i < 16; ++i) { o0[i] = 0.f; o1[i] = 0.f; }
    for (int kt = 0; kt < 5; ++kt) {
        const int kb = i0 - 128 + 32 * kt;
        if (kb + 31 < 0) continue;
        const int ik = kb + qq, ikc = ik < 0 ? 0 : ik;
        u32x4 vreg[4];
#pragma unroll
        for (int i = 0; i < 4; ++i) { int key = kb + (lane >> 3) + 8 * i; key = key < 0 ? 0 : key; vreg[i] = *(const u32x4*)(Vb + (size_t)d * key * QKV_LD + (lane & 7) * 8); }
        const bf16_t* kp = Kb + (size_t)d * ikc * QKV_LD;
        f32x16 s;
#pragma unroll
        for (int i = 0; i < 16; ++i) s[i] = 0.f;
#pragma unroll
        for (int ds = 0; ds < 4; ++ds) { const bf16x8 kf = *(const bf16x8*)(kp + 16 * ds + 8 * hi); s = __builtin_amdgcn_mfma_f32_32x32x16_bf16(kf, qf[ds], s, 0, 0, 0); }
        float p[16]; float tmax = -1e30f;
#pragma unroll
        for (int rr = 0; rr < 16; ++rr) { const int kap = crow(rr, hi); const int st = qq + 128 - 32 * kt - kap; const bool valid = (st >= 0) && (st <= 128) && (kb + kap >= 0);
            p[rr] = valid ? (s[rr] * c1 - c2 * (float)st) : -1e30f; tmax = fmaxf(tmax, p[rr]); }
        tmax = fmaxf(tmax, __shfl_xor(tmax, 32));
        const float m_new = fmaxf(m_run, tmax), alpha = exp2f(m_run - m_new);
        float psum = 0.f;
#pragma unroll
        for (int rr = 0; rr < 16; ++rr) { p[rr] = (p[rr] > -1e29f) ? exp2f(p[rr] - m_new) : 0.f; psum += p[rr]; }
        psum += __shfl_xor(psum, 32);
        l_run = l_run * alpha + psum; m_run = m_new;
#pragma unroll
        for (int i = 0; i < 16; ++i) { o0[i] *= alpha; o1[i] *= alpha; }
#pragma unroll
        for (int i = 0; i < 4; ++i) *(LAS u32x4*)(vlds + ((lane >> 3) + 8 * i) * 128 + (lane & 7) * 16) = vreg[i];
        LDS_WAIT();
#pragma unroll
        for (int j = 0; j < 2; ++j) {
            u32x4 pw; pw.x = pk2(p[8 * j + 0], p[8 * j + 1]); pw.y = pk2(p[8 * j + 2], p[8 * j + 3]); pw.z = pk2(p[8 * j + 4], p[8 * j + 5]); pw.w = pk2(p[8 * j + 6], p[8 * j + 7]);
            const bf16x8 pf = __builtin_bit_cast(bf16x8, pw);
            const int q_ = (lane & 15) >> 2, p_ = lane & 3, blk = (lane >> 4) & 1;
            LAS unsigned char* rb = vlds + (16 * j + 4 * hi + q_) * 128 + blk * 32 + 8 * p_;
            const v4i16_t a0 = __builtin_amdgcn_ds_read_tr16_b64_v4i16((LAS v4i16_t*)(rb)), a1 = __builtin_amdgcn_ds_read_tr16_b64_v4i16((LAS v4i16_t*)(rb + 8 * 128));
            const v4i16_t b0 = __builtin_amdgcn_ds_read_tr16_b64_v4i16((LAS v4i16_t*)(rb + 64)), b1 = __builtin_amdgcn_ds_read_tr16_b64_v4i16((LAS v4i16_t*)(rb + 8 * 128 + 64));
            const bf16x8 v0 = {a0[0], a0[1], a0[2], a0[3], a1[0], a1[1], a1[2], a1[3]}, v1 = {b0[0], b0[1], b0[2], b0[3], b1[0], b1[1], b1[2], b1[3]};
            o0 = __builtin_amdgcn_mfma_f32_32x32x16_bf16(v0, pf, o0, 0, 0, 0);
            o1 = __builtin_amdgcn_mfma_f32_32x32x16_bf16(v1, pf, o1, 0, 0, 0);
        }
        LDS_WAIT();
    }
    const float inv = 1.0f / l_run;
    if (do_store) {
#pragma unroll
    for (int q4 = 0; q4 < 4; ++q4) {
        u32x2 w0, w1;
        w0.x = pk2(o0[4 * q4] * inv, o0[4 * q4 + 1] * inv); w0.y = pk2(o0[4 * q4 + 2] * inv, o0[4 * q4 + 3] * inv);
        w1.x = pk2(o1[4 * q4] * inv, o1[4 * q4 + 1] * inv); w1.y = pk2(o1[4 * q4 + 2] * inv, o1[4 * q4 + 3] * inv);
        *(u32x2*)(qptr + 8 * q4 + 4 * hi) = w0; *(u32x2*)(qptr + 32 + 8 * q4 + 4 * hi) = w1;
    }
    if (hi == 0) ALSE[((size_t)g * MTOK + rowq) * 4 + hg] = m_run + log2f(l_run);
    }
}

constexpr int SC_NB = 16;
typedef float f32x2 __attribute__((ext_vector_type(2)));
__device__ __forceinline__ void scan_block(const Args& a, LAS unsigned char* ldsb, int bx, int tid) {
    LAS float* OP = (LAS float*)ldsb;
    LAS float* VV = OP + 2 * SC_NB * 320;
    LAS float* YP = VV + 2 * SC_NB * 16;
    const int lane = tid & 63, w = tid >> 6;
    const int bh = (bx & 7) * 8 + ((bx >> 3) >> 2), qtr = (bx >> 3) & 3, b = bh >> 3, h = bh & 7;
    const bf16_t* PRW = (const bf16_t*)(a.ws + OFF_PRW); const bf16_t* LWA = (const bf16_t*)(a.ws + OFF_LW);
    float* YRAW = (float*)(a.ws + OFF_YRAW);
    const size_t mb = (size_t)b * SEQ;
    const bool is_scan = w < 4;
    const int rl = (w & 3) * 4 + (lane >> 4), j = lane & 15;
    f32x2 S01 = {0.f, 0.f}, S23 = {0.f, 0.f};
    const int pt = tid & 255, s_ = pt >> 4, k4 = (pt & 15) * 4, hc4 = h * 64 + k4;
    const f32x4 kk_c = *(const f32x4*)(a.in[10] + hc4), ka_c = *(const f32x4*)(a.in[11] + hc4), rk_c = *(const f32x4*)(a.in[12] + hc4);
    const f32x4 mu_r = *(const f32x4*)(a.in[4] + hc4), mu_k = *(const f32x4*)(a.in[4] + 512 + hc4), mu_v = *(const f32x4*)(a.in[4] + 1024 + hc4);
    float* RKB = (float*)(a.ws + OFF_RSPB);
    const float* KN = (const float*)(a.ws + OFF_RK);
    u32x2 lr[2][2], lk[2][2], lv[2][2], lw_[2], la_[2]; float kn_[2];
#define SC_LOAD(SET, nb) do { const int t = (nb) * SC_NB + s_; const bf16_t* row = PRW + (mb + t) * PRW_LD + hc4; const bf16_t* prw_ = t > 0 ? row - PRW_LD : row; \
        lr[SET][0] = *(const u32x2*)row; lr[SET][1] = *(const u32x2*)prw_; lk[SET][0] = *(const u32x2*)(row + 512); lk[SET][1] = *(const u32x2*)(prw_ + 512); \
        lv[SET][0] = *(const u32x2*)(row + 1024); lv[SET][1] = *(const u32x2*)(prw_ + 1024); \
        lw_[SET] = *(const u32x2*)(LWA + (mb + t) * 1024 + hc4); la_[SET] = *(const u32x2*)(LWA + (mb + t) * 1024 + 512 + hc4); kn_[SET] = KN[(mb + t) * 8 + h]; } while (0)
#define SC_U4(w, f) do { f[0] = bflo((w).x); f[1] = bfhi((w).x); f[2] = bflo((w).y); f[3] = bfhi((w).y); } while (0)
#define SC_PREP(SET, nb) do { LAS float* opb = OP + ((nb) & 1) * (SC_NB * 320) + s_ * 320 + k4; LAS float* vvb = VV + ((nb) & 1) * (SC_NB * 16) + s_ * 16; \
        const float tm = ((nb) * SC_NB + s_) > 0 ? 1.f : 0.f; \
        f32x4 cr, pr_, ck, pk_, cv, pv_, sw, sa_; SC_U4(lr[SET][0], cr); SC_U4(lr[SET][1], pr_); SC_U4(lk[SET][0], ck); SC_U4(lk[SET][1], pk_); SC_U4(lv[SET][0], cv); SC_U4(lv[SET][1], pv_); SC_U4(lw_[SET], sw); SC_U4(la_[SET], sa_); \
        const f32x4 r_ = cr + (pr_ * tm - cr) * mu_r, k_ = ck + (pk_ * tm - ck) * mu_k, v_ = cv + (pv_ * tm - cv) * mu_v; \
        f32x4 dec; _Pragma("unroll") for (int e = 0; e < 4; ++e) dec[e] = __expf(-0.6065306597126334f * sw[e]); \
        const f32x4 kk = k_ * kk_c * kn_[SET]; const f32x4 kp = k_ * ((sa_ - 1.0f) * ka_c + 1.0f); \
        *(LAS f32x4*)(opb) = dec; *(LAS f32x4*)(opb + 64) = -kk; *(LAS f32x4*)(opb + 128) = kk * sa_; *(LAS f32x4*)(opb + 192) = kp; *(LAS f32x4*)(opb + 256) = r_; \
        if (((pt & 15) >> 2) == qtr) *(LAS f32x4*)(vvb + (pt & 3) * 4) = v_; \
        { const f32x4 q4 = r_ * kp * rk_c; float rk = (q4[0] + q4[1]) + (q4[2] + q4[3]); rk = allsum16(rk); \
          if ((s_ & 3) == qtr && (pt & 15) == 0) RKB[(mb + (nb) * SC_NB + s_) * 8 + h] = rk; } } while (0)
#define SC_YRED(nb) do { const LAS float* ypb = YP + ((nb) & 1) * (SC_NB * 256); const int s = pt >> 4, r = pt & 15; \
        const LAS f32x4* q4 = (const LAS f32x4*)(ypb + s * 256 + r * 16); const f32x4 y0 = q4[0], y1 = q4[1], y2 = q4[2], y3 = q4[3]; \
        const float ysum = (((y0[0] + y0[1]) + (y0[2] + y0[3])) + ((y1[0] + y1[1]) + (y1[2] + y1[3]))) + (((y2[0] + y2[1]) + (y2[2] + y2[3])) + ((y3[0] + y3[1]) + (y3[2] + y3[3]))); \
        YRAW[(mb + (nb) * SC_NB + s) * 512 + h * 64 + 16 * qtr + r] = ysum; } while (0)
    constexpr int NBATCH = SEQ / SC_NB;
#if (PROBE_MASK >> 15) & 1
    int nrep_ = 2; asm volatile("" : "+s"(nrep_));
#pragma unroll 1
    for (int rep_ = 0; rep_ < nrep_; ++rep_) {
    S01 = (f32x2){0.f, 0.f}; S23 = (f32x2){0.f, 0.f};
#else
    {
#endif
    if (!is_scan) { SC_LOAD(0, 0); SC_LOAD(1, 1); SC_PREP(0, 0); SC_LOAD(0, 2); }
    __syncthreads();
    if (is_scan) __builtin_amdgcn_s_setprio(3);
#pragma unroll 1
    for (int it2 = 0; it2 < NBATCH; it2 += 2) {
#pragma unroll
        for (int par = 0; par < 2; ++par) {
            const int it = it2 + par;
            if (is_scan) {
                const LAS float* opb = OP + par * (SC_NB * 320); const LAS float* vvb = VV + par * (SC_NB * 16) + rl; LAS float* ypb = YP + par * (SC_NB * 256) + (w & 3) * 64 + lane;
                const LAS f32x4* op = (const LAS f32x4*)opb + j;
                f32x4 wv = op[0], av = op[16], bv = op[32], kv = op[48], rv = op[64]; float vv = vvb[0];
#pragma unroll
                for (int s = 0; s < SC_NB; ++s) {
                    f32x4 wn, an, bn, kn, rn; float vn;
                    if (s + 1 < SC_NB) { const LAS f32x4* opn = op + (s + 1) * 80; wn = opn[0]; an = opn[16]; bn = opn[32]; kn = opn[48]; rn = opn[64]; vn = vvb[(s + 1) * 16]; }
                    const f32x2 vv2 = {vv, vv};
                    f32x2 t2 = S01 * (f32x2){av[0], av[1]}; t2 = S23 * (f32x2){av[2], av[3]} + t2;
                    float sa = t2[0] + t2[1]; sa = allsum16(sa);
                    const f32x2 sa2 = {sa, sa};
                    const f32x2 T01 = (f32x2){kv[0], kv[1]} * vv2 + S01 * (f32x2){wv[0], wv[1]}, T23 = (f32x2){kv[2], kv[3]} * vv2 + S23 * (f32x2){wv[2], wv[3]};
                    S01 = (f32x2){bv[0], bv[1]} * sa2 + T01;
                    S23 = (f32x2){bv[2], bv[3]} * sa2 + T23;
                    f32x2 y2 = S01 * (f32x2){rv[0], rv[1]}; y2 = S23 * (f32x2){rv[2], rv[3]} + y2;
                    ypb[s * 256] = y2[0] + y2[1];
                    if (s + 1 < SC_NB) { wv = wn; av = an; bv = bn; kv = kn; rv = rn; vv = vn; }
                }
            } else {
                if (it >= 1) SC_YRED(it - 1);
                if (it + 1 < NBATCH) { SC_PREP(1 - par, it + 1); if (it + 3 < NBATCH) SC_LOAD(1 - par, it + 3); }
            }
            __syncthreads();
        }
    }
    __builtin_amdgcn_s_setprio(0);
    if (!is_scan) SC_YRED(NBATCH - 1);
    __syncthreads();
    }
#undef SC_LOAD
#undef SC_PREP
#undef SC_YRED
}

#define XB_TMO      128
#define XB_XCNT(j)  (256  + 64 * (j))
#define XB_XSUB(j)  (1280 + 64 * (j))
#define XB_XGEN(j)  (2304 + 64 * (j))
#define XB_TOP      3328
#define XB_TOPGEN   3392
#define XCD_BAR_WORDS 3456
#define XB_SPIN_CAP (1u << 18)

__device__ __forceinline__ unsigned xb_ld(unsigned* p)              { return __hip_atomic_load(p, __ATOMIC_RELAXED, __HIP_MEMORY_SCOPE_AGENT); }
__device__ __forceinline__ unsigned xb_add(unsigned* p, unsigned v) { return __hip_atomic_fetch_add(p, v, __ATOMIC_RELAXED, __HIP_MEMORY_SCOPE_AGENT); }
__device__ __forceinline__ unsigned xb_xcc_id() { return (unsigned)__builtin_amdgcn_s_getreg((3 << 11) | 20) & 0xFu; }
#define XB_SPIN(cond, bar) do { unsigned _sp = 0; while (cond) { __builtin_amdgcn_s_sleep(1); \
    if ((++_sp & 255u) == 0u) { if (xb_ld(&(bar)[XB_TMO])) break; if (_sp > XB_SPIN_CAP) { atomicAdd(&(bar)[XB_TMO], 1u); break; } } } } while (0)

struct XcdBarrier {
    unsigned* bar; unsigned x;
    volatile LAS unsigned* st;
};

__device__ __forceinline__ XcdBarrier xcd_barrier_post(unsigned* bar, volatile LAS unsigned* st) {
    XcdBarrier b; b.bar = bar; b.x = xb_xcc_id(); b.st = st;
    if (threadIdx.x == 0) (void)xb_add(&bar[XB_XCNT(b.x)], 1u);
    return b;
}
__device__ __forceinline__ void xcd_barrier_complete(unsigned* bar, unsigned x, unsigned& nloc, unsigned& nx) {
    const unsigned G = gridDim.x * gridDim.y * gridDim.z;
    unsigned sum, cnt, mine, sp = 0u;
    for (;;) {
        sum = 0u; cnt = 0u; mine = 0u;
#pragma unroll
        for (unsigned j = 0; j < 16; ++j) { const unsigned c = xb_ld(&bar[XB_XCNT(j)]); sum += c; cnt += (c > 0u) ? 1u : 0u; mine = (j == x) ? c : mine; }
        if (sum == G) break;
        __builtin_amdgcn_s_sleep(1);
        if ((++sp & 255u) == 0u) { if (xb_ld(&bar[XB_TMO])) break; if (sp > XB_SPIN_CAP) { atomicAdd(&bar[XB_TMO], 1u); break; } }
    }
    nloc = mine > 0u ? mine : 1u; nx = cnt > 0u ? cnt : 1u;
}

__device__ __forceinline__ void xcd_barrier(const XcdBarrier& b) {
    asm volatile("s_waitcnt vmcnt(0)" ::: "memory");
    __syncthreads();
    if (threadIdx.x == 0) {
        unsigned* bar = b.bar;
        __builtin_amdgcn_s_waitcnt(0);
        unsigned nloc = b.st[0], nx = b.st[1];
        if (nloc == 0u) { xcd_barrier_complete(bar, b.x, nloc, nx); b.st[0] = nloc; b.st[1] = nx; }
        const unsigned old = xb_add(&bar[XB_XSUB(b.x)], 1u);
        const unsigned gen = old / nloc;
        if (old + 1u == (gen + 1u) * nloc) {
            __builtin_amdgcn_fence(__ATOMIC_RELEASE, "agent");
            asm volatile("s_waitcnt vmcnt(0)" ::: "memory");
            const unsigned og = xb_add(&bar[XB_TOP], 1u);
            const unsigned tg = og / nx;
            if (og + 1u == (tg + 1u) * nx) xb_add(&bar[XB_TOPGEN], 1u);
            else XB_SPIN(xb_ld(&bar[XB_TOPGEN]) == tg, bar);
            __builtin_amdgcn_fence(__ATOMIC_ACQUIRE, "agent");
            xb_add(&bar[XB_XGEN(b.x)], 1u);
            asm volatile("s_waitcnt vmcnt(0)" ::: "memory");
        } else {
            XB_SPIN(xb_ld(&bar[XB_XGEN(b.x)]) == gen, bar);
            __builtin_amdgcn_fence(__ATOMIC_ACQUIRE, "agent");
            asm volatile("s_waitcnt vmcnt(0)" ::: "memory");
        }
    }
    __syncthreads();
}

__device__ __forceinline__ int opaque_int(int n) { asm volatile("" : "+s"(n)); return n; }

__global__ void __launch_bounds__(NWV * 64, 2) mk_fwd(Args a) {
    extern __shared__ __attribute__((aligned(16))) unsigned char lds_raw[];
    LAS unsigned char* lds = (LAS unsigned char*)lds_raw;
    const int tid = threadIdx.x, lane = tid & 63, wave = __builtin_amdgcn_readfirstlane(tid >> 6);
    const int G = gridDim.x, bx = blockIdx.x;
    const int gw = bx * NWV + wave, NGW = G * NWV;
    const int gt = bx * (NWV * 64) + tid, NGT = G * NWV * 64;
    unsigned char* ws = a.ws;
    bf16_t* W1T = (bf16_t*)(ws + OFF_W1T); bf16_t* WLORA = (bf16_t*)(ws + OFF_WLORA); bf16_t* WA = (bf16_t*)(ws + OFF_WA); bf16_t* WB = (bf16_t*)(ws + OFF_WB);
    bf16_t* WOUT = (bf16_t*)(ws + OFF_WOUT); bf16_t* WUP = (bf16_t*)(ws + OFF_WUP); bf16_t* WDN = (bf16_t*)(ws + OFF_WDN); bf16_t* WPG = (bf16_t*)(ws + OFF_WPG); bf16_t* WPLE = (bf16_t*)(ws + OFF_WPLE);
    float* RS0 = (float*)(ws + OFF_RS0); float* RSPA = (float*)(ws + OFF_RSPA); float* RSPB = (float*)(ws + OFF_RSPB); float* RK = (float*)(ws + OFF_RK); float* ALSE = (float*)(ws + OFF_ALSE);
    bf16_t* PB = (bf16_t*)(ws + OFF_PB); bf16_t* XB = (bf16_t*)(ws + OFF_XB); bf16_t* PRW = (bf16_t*)(ws + OFF_PRW); bf16_t* QKV = (bf16_t*)(ws + OFF_QKV);
    bf16_t* LW = (bf16_t*)(ws + OFF_LW); bf16_t* AA = (bf16_t*)(ws + OFF_AA); bf16_t* GG = (bf16_t*)(ws + OFF_GG); bf16_t* ALORA = (bf16_t*)(ws + OFF_ALORA);
    float* YRAW = (float*)(ws + OFF_YRAW); bf16_t* YA = (bf16_t*)(ws + OFF_YA); bf16_t* YB = (bf16_t*)(ws + OFF_YB); bf16_t* MERGED = (bf16_t*)(ws + OFF_MERGED);
    bf16_t* UU = (bf16_t*)(ws + OFF_U); bf16_t* HMID = (bf16_t*)(ws + OFF_HMID); bf16_t* PL = (bf16_t*)(ws + OFF_PL);
    bf16_t* GATE = (bf16_t*)a.out;
    const int lo = a.ph_lo, hi = a.ph_hi;
    XcdBarrier xbar; xbar.bar = (unsigned*)(ws + OFF_CTL); xbar.x = 0; xbar.st = nullptr;
    if (hi - lo > 2) {
        if (tid < 2) ((volatile LAS unsigned*)(lds + 131072 + 512))[tid] = 0u;
        __syncthreads();
        xbar = xcd_barrier_post((unsigned*)(ws + OFF_CTL), (volatile LAS unsigned*)(lds + 131072 + 512));
        cg::this_grid().sync();
    }
#ifndef ONLY_PHASE
#define ONLY_PHASE -1
#endif
#ifndef PROBE_MASK
#define PROBE_MASK 0
#endif
#define REPS(k) ((((PROBE_MASK >> (k)) & 1) != 0) ? opaque_int(2) : 1)
#define IN(k) ((ONLY_PHASE < 0 || ONLY_PHASE == (k) || (ONLY_PHASE == 8 && (k) == 10) || (ONLY_PHASE == 9 && (k) == 11)) && lo <= (k) && (k) < hi)
#if (PROBE_MASK >> 13) & 1
#define SEAM(k) do { if (IN(k) && IN((k) + 1)) { xcd_barrier(xbar); xcd_barrier(xbar); } } while (0)
#else
#define SEAM(k) do { if (IN(k) && IN((k) + 1)) xcd_barrier(xbar); } while (0)
#endif

    if (IN(0)) for (int rep_ = 0; rep_ < REPS(0); ++rep_) {
        LAS float* scr = (LAS float*)(lds + wave * 16384);
        constexpr int I_WIN = 16 * 129, I_WG = 16 * 64;
        for (int it = gw; it < I_WIN + I_WG; it += NGW) {
            int r = it;
            if (r < I_WIN) { const int kb = r / 129, nb = r % 129, n0 = 32 * nb; tr_item(a.in[3], 4128, 64 * kb, n0, a.in[2], W1T, DM, n0 < RWC ? n0 : n0 + 224, scr, lane); continue; } r -= I_WIN;
            { const int kb = r / 64, nb = r % 64; tr_item(a.in[17], 2048, 64 * kb, 32 * nb, a.in[2], W1T, DM, 4352 + 32 * nb, scr, lane); }
        }
        for (int e = gt; e < 224 * DM / 8; e += NGT) *(u32x4*)(W1T + (size_t)RWC * DM + (size_t)e * 8) = (u32x4){0u, 0u, 0u, 0u};
        for (int m0 = gw * 4; m0 < MTOK; m0 += NGW * 4) {
            f32x4 v[4][4];
#pragma unroll
            for (int r = 0; r < 4; ++r) { const f32x4* xr = (const f32x4*)(a.in[0] + (size_t)(m0 + r) * DM) + lane;
#pragma unroll
                for (int jj = 0; jj < 4; ++jj) v[r][jj] = __builtin_nontemporal_load(xr + 64 * jj); }
#pragma unroll
            for (int r = 0; r < 4; ++r) { float sq = 0.f;
#pragma unroll
                for (int jj = 0; jj < 4; ++jj) sq += (v[r][jj][0] * v[r][jj][0] + v[r][jj][1] * v[r][jj][1]) + (v[r][jj][2] * v[r][jj][2] + v[r][jj][3] * v[r][jj][3]);
                sq = wave_sum(sq); if (lane == 0) RS0[m0 + r] = rsqrtf(sq * (1.0f / DM) + NEPS);
                u32x2* o8 = (u32x2*)(XB + (size_t)(m0 + r) * DM) + lane;
#pragma unroll
                for (int jj = 0; jj < 4; ++jj) { u32x2 o; o.x = pk2(v[r][jj][0], v[r][jj][1]); o.y = pk2(v[r][jj][2], v[r][jj][3]); o8[64 * jj] = o; } }
        }
        __syncthreads();
    }
    SEAM(0);
    if (IN(1)) for (int rep_ = 0; rep_ < REPS(1); ++rep_) {
        pg8::Gemm g{XB, W1T, MTOK, N1, DM}; pg8::StaticOrder S; S.init(MTOK, N1, G, bx);
        EpiG1 E{PRW, QKV, GATE, RS0, a.in[18]};
        pg8::gemm_phase<EpiG1, pg8::StaticOrder, true, true>(lds, g, S, E);
        if (bx >= 128 && G == 256) {
            const int gw2 = (bx - 128) * NWV + wave, NGW2 = 128 * NWV, gt2 = (bx - 128) * (NWV * 64) + tid, NGT2 = 128 * NWV * 64;
            LAS float* scr = (LAS float*)(lds + wave * 16384);
            constexpr int I_WA = 8 * 32, I_WB = 4 * 32, I_WO = 16 * 32, I_WUP = 16 * 192, I_WD = 48 * 32, I_WPG = 16 * 32, I_WPLE = 4 * 32;
            constexpr int NIT2 = I_WA + I_WB + I_WO + I_WUP + I_WD + I_WPG + I_WPLE;
            for (int it = gw2; it < NIT2; it += NGW2) {
                int r = it;
                if (r < I_WA) { tr_matrix_item(a.in[15], 512, DM, nullptr, WA, r, scr, lane); continue; } r -= I_WA;
                if (r < I_WB) { tr_matrix_item(a.in[16], 256, DM, nullptr, WB, r, scr, lane); continue; } r -= I_WB;
                if (r < I_WO) { tr_matrix_item(a.in[19], DM, DM, nullptr, WOUT, r, scr, lane); continue; } r -= I_WO;
                if (r < I_WUP) { const int kb = r / 192, nb = r % 192, n0 = 32 * nb, jj = n0 < DFF ? n0 : n0 - DFF;
                    tr_item(a.in[21], 6144, 64 * kb, n0, a.in[20], WUP, DM, (jj / 128) * 256 + (n0 < DFF ? 0 : 128) + (jj % 128), scr, lane); continue; } r -= I_WUP;
                if (r < I_WD) { tr_matrix_item(a.in[24], DFF, DM, nullptr, WDN, r, scr, lane); continue; } r -= I_WD;
                if (r < I_WPG) { tr_matrix_item(a.in[26], DM, DM, a.in[25], WPG, r, scr, lane); continue; } r -= I_WPG;
                tr_matrix_item(a.in[27], 256, DM, nullptr, WPLE, r, scr, lane);
            }
            for (int e = gt2; e < NLORA * KLORA; e += NGT2) { const int n = e / KLORA, k = e % KLORA; float v = 0.f;
                if (n < 512) { if (k < 64) v = a.in[6][k * 512 + n]; } else if (n < 1024) { if (k >= 64 && k < 128) v = a.in[8][(k - 64) * 512 + (n - 512)]; } else { if (k >= 128 && k < 288) v = a.in[9][(k - 128) * 512 + (n - 1024)]; }
                WLORA[e] = (bf16_t)f2bf(v); }
        for (int c0 = gt2; c0 < MTOK * 256 / 8; c0 += NGT2 * 4) {
            f32x4 p0[4], p1[4];
#pragma unroll
            for (int r = 0; r < 4; ++r) { const int c = c0 + r * NGT2; if (c < MTOK * 256 / 8) { const f32x4* pp = (const f32x4*)(a.in[1] + (size_t)c * 8); p0[r] = __builtin_nontemporal_load(pp); p1[r] = __builtin_nontemporal_load(pp + 1); } }
#pragma unroll
            for (int r = 0; r < 4; ++r) { const int c = c0 + r * NGT2; if (c < MTOK * 256 / 8) { u32x4 o; o.x = pk2(p0[r][0], p0[r][1]); o.y = pk2(p0[r][2], p0[r][3]); o.z = pk2(p1[r][0], p1[r][1]); o.w = pk2(p1[r][2], p1[r][3]); *(u32x4*)(PB + (size_t)c * 8) = o; } }
        }
            __syncthreads();
        }
    }
    SEAM(1);
    if (IN(2)) for (int rep_ = 0; rep_ < REPS(2); ++rep_) {
        for (int m = gw; m < MTOK; m += NGW) {
            const int t = m & (SEQ - 1);
            const bf16_t* prow = PRW + (size_t)m * PRW_LD; const bf16_t* qrow = PRW + (size_t)(t > 0 ? m - 1 : m) * PRW_LD;
            const float tm = t > 0 ? 1.f : 0.f;
            u32x4 lc = {0u, 0u, 0u, 0u}, lp = {0u, 0u, 0u, 0u};
            const int c8 = lane * 8;
            const u32x4 kc = *(const u32x4*)(prow + 512 + c8), kp_ = *(const u32x4*)(qrow + 512 + c8);
            if (lane < 36) { lc = *(const u32x4*)(prow + 1536 + 8 * lane); lp = *(const u32x4*)(qrow + 1536 + 8 * lane); }
            {
                float kc8[8], kp8[8]; unpack8(kc, kc8); unpack8(kp_, kp8);
                const f32x4 mk0 = *(const f32x4*)(a.in[4] + 512 + c8), mk1 = *(const f32x4*)(a.in[4] + 512 + c8 + 4), kk0 = *(const f32x4*)(a.in[10] + c8), kk1 = *(const f32x4*)(a.in[10] + c8 + 4);
                float ss = 0.f;
#pragma unroll
                for (int e = 0; e < 8; ++e) { const float muv = e < 4 ? mk0[e] : mk1[e - 4], kkv = e < 4 ? kk0[e] : kk1[e - 4]; const float kk = (kc8[e] + (kp8[e] * tm - kc8[e]) * muv) * kkv; ss += kk * kk; }
                ss = allsum8(ss);
                if ((lane & 7) == 0) RK[(size_t)m * 8 + (lane >> 3)] = rsqrtf(fmaxf(ss, 1e-24f)); }
            if (lane < 36) {
                const int c = 1536 + 8 * lane; float cur[8], prv[8]; unpack8(lc, cur); unpack8(lp, prv);
                const f32x4 mu0 = *(const f32x4*)(a.in[4] + c), mu1 = *(const f32x4*)(a.in[4] + c + 4); float o[8];
#pragma unroll
                for (int e = 0; e < 8; ++e) { const float muv = e < 4 ? mu0[e] : mu1[e - 4]; const float pm = cur[e] + (prv[e] * tm - cur[e]) * muv;
                    o[e] = (c < 1600) ? (1.0f - 2.0f * __builtin_amdgcn_rcpf(1.0f + __expf(2.0f * pm))) : ((c < 1664) ? pm : sigmoidf_(pm)); }
                *(u32x4*)(ALORA + (size_t)m * KLORA + 8 * lane) = pack8(o);
            } else if (lane < 48) *(u32x4*)(ALORA + (size_t)m * KLORA + 8 * lane) = (u32x4){0u, 0u, 0u, 0u};
        }
    }
    SEAM(2);
    if (IN(3)) for (int rep_ = 0; rep_ < REPS(3); ++rep_) {
        pg8::Gemm g{ALORA, WLORA, MTOK, NLORA, KLORA}; pg8::StaticOrder S; S.init(MTOK, NLORA, G, bx);
        EpiLora E{LW, GG, a.in[5], a.in[7]};
        pg8::gemm_phase<EpiLora, pg8::StaticOrder, true, true>(lds, g, S, E);
    }
    SEAM(3);
    if (IN(4)) {
#if (PROBE_MASK >> 14) & 1
        { int ds_ = 0; asm volatile("" : "+s"(ds_)); for (int u = gw; u < 3 * 4096; u += NGW) attn_unit(QKV, ALSE, u, lane, lds + wave * 4096, ds_); }
#endif
        for (int u = gw; u < 3 * 4096; u += NGW) attn_unit(QKV, ALSE, u, lane, lds + wave * 4096);
        __syncthreads();
        scan_block(a, lds, bx, tid);
        __syncthreads();
    }
    SEAM(4);
    if (IN(5)) for (int rep_ = 0; rep_ < REPS(5); ++rep_) {
        for (int m = gw; m < MTOK; m += NGW) {
            const int t = m & (SEQ - 1); const float tm = t > 0 ? 1.f : 0.f;
            const bf16_t* prow = PRW + (size_t)m * PRW_LD + 1024; const bf16_t* qrow = PRW + (size_t)(t > 0 ? m - 1 : m) * PRW_LD + 1024;
            const int c8 = lane * 8, hh = lane >> 3;
            const f32x4 y0 = *(const f32x4*)(YRAW + (size_t)m * 512 + c8), y1 = *(const f32x4*)(YRAW + (size_t)m * 512 + c8 + 4);
            const u32x4 cvw = *(const u32x4*)(prow + c8), pvw = *(const u32x4*)(qrow + c8), gqw = *(const u32x4*)(GG + (size_t)m * 512 + c8);
            const float rk = RSPB[(size_t)m * 8 + hh];
            u32x4 ao0 = {0u, 0u, 0u, 0u}, ao1 = ao0, ao2 = ao0; float l0 = 0.f, l1 = 0.f, l2 = 0.f;
            if (lane < 32) { const bf16_t* qp = QKV + (size_t)m * QKV_LD + c8; ao0 = *(const u32x4*)qp; ao1 = *(const u32x4*)(qp + 256); ao2 = *(const u32x4*)(qp + 512);
                l0 = ALSE[((size_t)0 * MTOK + m) * 4 + hh]; l1 = ALSE[((size_t)1 * MTOK + m) * 4 + hh]; l2 = ALSE[((size_t)2 * MTOK + m) * 4 + hh]; }
            const f32x4 lg0 = *(const f32x4*)(a.in[13] + c8), lg1 = *(const f32x4*)(a.in[13] + c8 + 4), lb0 = *(const f32x4*)(a.in[14] + c8), lb1 = *(const f32x4*)(a.in[14] + c8 + 4);
            const f32x4 mv0 = *(const f32x4*)(a.in[4] + 1024 + c8), mv1 = *(const f32x4*)(a.in[4] + 1024 + c8 + 4);
            float yv[8] = {y0[0], y0[1], y0[2], y0[3], y1[0], y1[1], y1[2], y1[3]}, cv8[8], pv8[8], gq8[8], o[8];
            unpack8(cvw, cv8); unpack8(pvw, pv8); unpack8(gqw, gq8);
            float sm = ((yv[0] + yv[1]) + (yv[2] + yv[3])) + ((yv[4] + yv[5]) + (yv[6] + yv[7])); sm = allsum8(sm);
            const float mean = sm * (1.0f / 64.0f); float sq = 0.f;
#pragma unroll
            for (int e = 0; e < 8; ++e) { yv[e] -= mean; sq += yv[e] * yv[e]; }
            sq = allsum8(sq); const float rstd = rsqrtf(sq * (1.0f / 64.0f) + 64e-5f);
#pragma unroll
            for (int e = 0; e < 8; ++e) { const float lg = e < 4 ? lg0[e] : lg1[e - 4], lb = e < 4 ? lb0[e] : lb1[e - 4], muv = e < 4 ? mv0[e] : mv1[e - 4];
                const float yn = yv[e] * rstd * lg + lb, vv = cv8[e] + (pv8[e] * tm - cv8[e]) * muv; o[e] = (yn + rk * vv) * gq8[e]; }
            *(u32x4*)(YA + (size_t)m * 512 + c8) = pack8(o);
            if (lane < 32) { float a0[8], a1[8], a2[8], ob[8]; unpack8(ao0, a0); unpack8(ao1, a1); unpack8(ao2, a2);
                const float mx = fmaxf(l0, fmaxf(l1, l2)), w0 = exp2f(l0 - mx), w1 = exp2f(l1 - mx), w2 = exp2f(l2 - mx), inv = 1.0f / (w0 + w1 + w2);
#pragma unroll
                for (int e = 0; e < 8; ++e) ob[e] = (w0 * a0[e] + w1 * a1[e] + w2 * a2[e]) * inv;
                *(u32x4*)(YB + (size_t)m * 256 + c8) = pack8(ob); }
        }
    }
    SEAM(5);
    if (IN(6)) for (int rep_ = 0; rep_ < REPS(6); ++rep_) {
        { pg8::Gemm g{YA, WA, MTOK, DM, 512}; pg8::StaticOrder S; S.init(MTOK, DM, G, bx); EpiBranch<0> E{MERGED, GATE};
          pg8::gemm_phase<EpiBranch<0>, pg8::StaticOrder, true, true>(lds, g, S, E); }
        __syncthreads();
        { pg8::Gemm g{YB, WB, MTOK, DM, 256}; pg8::StaticOrder S; S.init(MTOK, DM, G, bx); EpiBranch<1> E{MERGED, GATE};
          pg8::gemm_phase<EpiBranch<1>, pg8::StaticOrder, true, true>(lds, g, S, E); }
    }
    SEAM(6);
    if (IN(7)) for (int rep_ = 0; rep_ < REPS(7); ++rep_) {
        pg8::Gemm g{MERGED, WOUT, MTOK, DM, DM}; pg8::StaticOrder S; S.init(MTOK, DM, G, bx);
        EpiRes<0, false> E{a.in[0], nullptr, XB, RSPA, nullptr, nullptr};
        pg8::gemm_phase<EpiRes<0, false>, pg8::StaticOrder, true, true>(lds, g, S, E);
    }
    SEAM(7);
    if (IN(8)) for (int rep_ = 0; rep_ < REPS(8); ++rep_) {
        pg8::Gemm g{XB, WUP, MTOK, 6144, DM}; pg8::StaticOrder S; S.init(MTOK, 6144, G, bx);
        EpiUpGlu E{HMID, RSPA, a.in[22], a.in[23], (LAS float*)(lds + 131072 + 4096), (float*)(ws + OFF_UA), (float*)(ws + OFF_UB)};
        pg8::gemm_phase<EpiUpGlu, pg8::StaticOrder, true, true>(lds, g, S, E);
    }
    SEAM(8);
    if (IN(9)) {
        const float* UA = (const float*)(ws + OFF_UA); const float* UB = (const float*)(ws + OFF_UB);
        for (int it = gt; it < 128 * 24 * 16; it += NGT) {
            const int c8 = it & 15, pn = (it >> 4) % 24, pm = it / (24 * 16);
            const int tc = pn * 256 + c8 * 8, gc = pn * 128 + c8 * 8;
            const bool first = (pm & 15) == 0;
            float o0[8], o1[8];
#pragma unroll
            for (int hv = 0; hv < 2; ++hv) {
                const float* a0p = UA + ((size_t)pm * 2) * 6144 + tc + hv * 128; const float* b0p = UB + ((size_t)(first ? pm : pm - 1) * 2) * 6144 + tc + hv * 128; const int wc_ = gc + hv * 3072;
                float u0[8], u1[8], um2[8], um1[8], r0[8], r1[8];
#pragma unroll
                for (int e4 = 0; e4 < 2; ++e4) { const f32x4 x0 = *(const f32x4*)(a0p + 4 * e4), x1 = *(const f32x4*)(a0p + 6144 + 4 * e4), y0 = *(const f32x4*)(b0p + 4 * e4), y1 = *(const f32x4*)(b0p + 6144 + 4 * e4);
                    const f32x4 k0 = *(const f32x4*)(a.in[22] + wc_ + 4 * e4), k1 = *(const f32x4*)(a.in[22] + 6144 + wc_ + 4 * e4), k2 = *(const f32x4*)(a.in[22] + 2 * 6144 + wc_ + 4 * e4), kb = *(const f32x4*)(a.in[23] + wc_ + 4 * e4);
#pragma unroll
                    for (int e = 0; e < 4; ++e) { u0[4 * e4 + e] = x0[e]; u1[4 * e4 + e] = x1[e]; um2[4 * e4 + e] = first ? 0.f : y0[e]; um1[4 * e4 + e] = first ? 0.f : y1[e];
                        r0[4 * e4 + e] = kb[e] + k0[e] * x0[e] + k1[e] * um1[4 * e4 + e] + k2[e] * um2[4 * e4 + e];
                        r1[4 * e4 + e] = kb[e] + k0[e] * x1[e] + k1[e] * x0[e] + k2[e] * um1[4 * e4 + e]; } }
#pragma unroll
                for (int e = 0; e < 8; ++e) { if (hv == 0) { o0[e] = gelu_tanh(r0[e]); o1[e] = gelu_tanh(r1[e]); } else { o0[e] *= r0[e]; o1[e] *= r1[e]; } }
            }
            *(u32x4*)(HMID + ((size_t)pm * 256) * DFF + gc) = pack8(o0); *(u32x4*)(HMID + ((size_t)pm * 256 + 1) * DFF + gc) = pack8(o1);
        }
    }
    SEAM(9);
    if (IN(12)) {
        { pg8::Gemm g{HMID, WDN, MTOK, DM, DFF}; pg8::StaticOrder S; S.init(MTOK, DM, G, bx);
          EpiRes<0, true> E{nullptr, XB, XB, RSPB, nullptr, nullptr};
          pg8::gemm_phase<EpiRes<0, true>, pg8::StaticOrder, true, true>(lds, g, S, E); }
        __syncthreads();
        { pg8::Gemm g{PB, WPLE, MTOK, DM, 256}; pg8::StaticOrder S; S.init(MTOK, DM, G, bx); EpiPlain E{PL, DM};
          pg8::gemm_phase<EpiPlain, pg8::StaticOrder, true, true>(lds, g, S, E); }
    }
    SEAM(12);
    if (IN(13)) {
        pg8::Gemm g{XB, WPG, MTOK, DM, DM}; pg8::StaticOrder S; S.init(MTOK, DM, G, bx);
        EpiRes<1, true> E{nullptr, XB, HMID  , RSPA, RSPB, PL};
        pg8::gemm_phase<EpiRes<1, true>, pg8::StaticOrder, true, true>(lds, g, S, E);
    }
    SEAM(13);
    if (IN(14)) {
        for (int m0 = gw * 4; m0 < MTOK; m0 += NGW * 4) {
            u32x2 w[4][4]; float rs[4];
#pragma unroll
            for (int r = 0; r < 4; ++r) { const u32x2* xr = (const u32x2*)(HMID + (size_t)(m0 + r) * DM) + lane;
#pragma unroll
                for (int jj = 0; jj < 4; ++jj) w[r][jj] = xr[64 * jj];
                rs[r] = rstd16(RSPA, m0 + r); }
#pragma unroll
            for (int r = 0; r < 4; ++r) { f32x4* orow = (f32x4*)(a.out + (size_t)(m0 + r) * DM) + lane; const f32x4* gr = (const f32x4*)a.in[28] + lane;
#pragma unroll
                for (int jj = 0; jj < 4; ++jj) { const f32x4 gf = gr[64 * jj]; const f32x4 v = {bflo(w[r][jj].x), bfhi(w[r][jj].x), bflo(w[r][jj].y), bfhi(w[r][jj].y)}; __builtin_nontemporal_store(v * rs[r] * gf, orow + 64 * jj); } }
        }
    }
#undef IN
#undef SEAM
}

extern "C" void kernel_launch(void* const* d_in, const int* in_sizes, int n_in, void* d_out, int out_size, void* d_ws, size_t ws_size, hipStream_t stream) {
    static int grid = 0;
    if (grid == 0) {
        if (n_in != 29 || out_size != MTOK * DM || ws_size < WS_NEED) { fprintf(stderr, "kernel_launch: unexpected shapes (n_in %d out %d ws %zu need %zu)\n", n_in, out_size, ws_size, (size_t)WS_NEED); grid = -1; return; }
        int dev = 0, cus = 0, per_cu = 0;
        hipGetDevice(&dev); hipDeviceGetAttribute(&cus, hipDeviceAttributeMultiprocessorCount, dev);
        if (hipFuncSetAttribute((const void*)mk_fwd, hipFuncAttributeMaxDynamicSharedMemorySize, LDS_BYTES) != hipSuccess) { fprintf(stderr, "kernel_launch: hipFuncSetAttribute failed\n"); grid = -1; return; }
        if (hipOccupancyMaxActiveBlocksPerMultiprocessor(&per_cu, (const void*)mk_fwd, NWV * 64, LDS_BYTES) != hipSuccess || per_cu < 1) { fprintf(stderr, "kernel_launch: occupancy query says %d\n", per_cu); per_cu = 1; }
        (void)hipGetLastError();
        grid = cus * per_cu; if (grid > 256) grid = 256;
        if (grid < 256) fprintf(stderr, "kernel_launch: grid %d < 256\n", grid);
    }
    if (grid < 0) return;
    if (hipMemsetAsync((char*)d_ws + OFF_CTL, 0, CTL_BYTES, stream) != hipSuccess) { fprintf(stderr, "kernel_launch: memset failed\n"); return; }
    Args a{};
    for (int i = 0; i < 29; ++i) a.in[i] = (const float*)d_in[i];
    a.out = (float*)d_out; a.ws = (unsigned char*)d_ws;
#if MK_MULTI
    for (int ph = 0; ph < N_PHASES; ++ph) { a.ph_lo = ph; a.ph_hi = ph + 1; hipLaunchKernelGGL(mk_fwd, dim3(grid), dim3(NWV * 64), LDS_BYTES, stream, a); }
#else
    a.ph_lo = 0; a.ph_hi = N_PHASES;
    void* args[] = {&a};
    hipError_t e = hipLaunchCooperativeKernel((const void*)mk_fwd, dim3(grid), dim3(NWV * 64), args, LDS_BYTES, stream);
    if (e != hipSuccess) fprintf(stderr, "kernel_launch: cooperative launch failed: %s (grid %d)\n", hipGetErrorString(e), grid);
#endif
}
```

```cpp
#include <hip/hip_runtime.h>
#include <hip/hip_cooperative_groups.h>
#include <cstdio>
#include <cstdint>
namespace cg = cooperative_groups;
#ifndef MK_MULTI
#define MK_MULTI 0
#endif
namespace pg8 {
#define PG8_LAS __attribute__((address_space(3)))
typedef unsigned short bf16_t;
typedef short bf16x8 __attribute__((ext_vector_type(8)));
typedef float f32x4 __attribute__((ext_vector_type(4)));
typedef unsigned u32x4 __attribute__((ext_vector_type(4)));
constexpr int BM = 256, BK = 64, HALF = 128, HTB = HALF * BK * 2  , STAGE_BYTES = 8 * HTB, NXCD = 8, WGM = 8;

__host__ __device__ __forceinline__ int lds_byte(int r, int c) { const int st = (r >> 4) * 2 + (c >> 5), rr = r & 15, cc = c & 31, ob = rr * 64 + cc * 2; return st * 1024 + (ob ^ (((ob >> 9) & 1) << 5)); }
__host__ __device__ __forceinline__ void stage_rc(int b, int& R, int& C) { const int st = b / 1024, sb = b % 1024, swz = sb ^ (((sb >> 9) & 1) << 5); R = (st >> 1) * 16 + swz / 64; C = (st & 1) * 32 + (swz % 64) / 2; }
__host__ __device__ __forceinline__ int perm32(int rho) { const int n = rho >> 4, i = rho & 15; return 8 * (i >> 2) + 4 * n + (i & 3); }

struct Unit { int pm, pn; };
struct Gemm { const bf16_t* A; const bf16_t* Bt; int M, N, K; };
struct StaticOrder {
    int nM, nN, nwg, G, c;
    __host__ __device__ void init(int M, int N, int G_, int c_) { nM = M / BM; nN = N / BM; nwg = nM * nN; G = G_; c = c_; }
    __host__ __device__ bool next(int i, Unit& u) const {
        const long L = (long)i * G + c; if (L >= nwg) return false;
        int wgid = (int)L; { const int q = nwg / NXCD, r = nwg % NXCD, xcd = wgid % NXCD, off = wgid / NXCD; wgid = (xcd < r ? xcd * (q + 1) : r * (q + 1) + (xcd - r) * q) + off; }
        const int nig = WGM * nN, gid = wgid / nig, fm = gid * WGM, gsz = (nM - fm) < WGM ? (nM - fm) : WGM;
        u.pm = fm + ((wgid % nig) % gsz); u.pn = (wgid % nig) / gsz; return true;
    }
    __device__ __forceinline__ long arow(int pm) const { return (long)pm * BM; }
    __device__ __forceinline__ void a_ready(const Unit&) const {}
    __device__ __forceinline__ void done(const Unit&) const {}
};
__device__ __forceinline__ unsigned cvt_pk_bf16(float lo, float hi) { unsigned r; asm volatile("v_cvt_pk_bf16_f32 %0, %1, %2" : "=v"(r) : "v"(lo), "v"(hi)); return r; }
typedef float f32x2 __attribute__((ext_vector_type(2)));
template <class Epi, class Sched, bool ALIGN_EPI = false, bool SP2 = false>
__device__ __forceinline__ void gemm_phase(PG8_LAS unsigned char* lds, const Gemm g, const Sched& S, const Epi& E) {
    const int tid = threadIdx.x, wid = __builtin_amdgcn_readfirstlane(tid >> 6), lane = tid & 63, wr = wid >> 2, wc = wid & 3, fr = lane & 15, fq = lane >> 4;
    const int K = g.K, nt = K / BK;
    unsigned voffA[2], voffB[2];
#pragma unroll
    for (int i = 0; i < 2; ++i) { int R, C; stage_rc(tid * 16 + i * 8192, R, C); const int Rb = Epi::PERM ? ((R & ~31) + perm32(R & 31)) : R;
        voffA[i] = (unsigned)(R * K + C) * 2u; voffB[i] = (unsigned)(Rb * K + C) * 2u; }
    const size_t kstep = (size_t)(BK * 2);
    const size_t hstep = (size_t)HALF * K * 2;
    const size_t tstep = 2 * hstep;
    const unsigned ldsw = (unsigned)wid * 1024u;
    const int aoff = lds_byte(wr * 64 + fr, fq * 8), boff = lds_byte(wc * 32 + fr, fq * 8);
#define PG8_SA(b, h) (((b) * 2 + (h)) * HTB)
#define PG8_SB(b, h) ((4 + (b) * 2 + (h)) * HTB)
#define PG8_STAGE(bufoff, gbase, voff) do { _Pragma("unroll") for (int _i = 0; _i < 2; ++_i) \
        __builtin_amdgcn_global_load_lds((const unsigned*)((const char*)(gbase) + (voff)[_i]), (PG8_LAS unsigned*)(lds + (bufoff) + ldsw + _i * 8192), 16, 0, 0); } while (0)
#define PG8_LDA(dst, b, h) do { _Pragma("unroll") for (int m = 0; m < 4; ++m) _Pragma("unroll") for (int k = 0; k < 2; ++k) dst[m][k] = *(const PG8_LAS bf16x8*)(lds + PG8_SA(b, h) + aoff + m * 2048 + k * 1024); } while (0)
#define PG8_LDB(dst, b, h) do { _Pragma("unroll") for (int n = 0; n < 2; ++n) _Pragma("unroll") for (int k = 0; k < 2; ++k) dst[n][k] = *(const PG8_LAS bf16x8*)(lds + PG8_SB(b, h) + boff + n * 2048 + k * 1024); } while (0)
#define PG8_MMA(ai, bj, At, Bt) do { __builtin_amdgcn_s_setprio(1); _Pragma("unroll") for (int m = 0; m < 4; ++m) _Pragma("unroll") for (int n = 0; n < 2; ++n) _Pragma("unroll") for (int k = 0; k < 2; ++k) \
        acc[ai][bj][m][n] = __builtin_amdgcn_mfma_f32_16x16x32_bf16(Bt[n][k], At[m][k], acc[ai][bj][m][n], 0, 0, 0); __builtin_amdgcn_s_setprio(0); } while (0)
#define PG8_WAIT_V(n) asm volatile("s_waitcnt vmcnt(" #n ")" ::: "memory")
#define PG8_WAIT_L(n) asm volatile("s_waitcnt lgkmcnt(" #n ")" ::: "memory")
#define PG8_BAR __builtin_amdgcn_s_barrier()
#define PG8_SCHED __builtin_amdgcn_sched_barrier(0)
    Unit cur, nxt; int ui = 0;
    if (!S.next(0, cur)) return;
    f32x4 acc[2][2][4][2];
#pragma unroll
    for (int a = 0; a < 2; ++a)
#pragma unroll
        for (int b = 0; b < 2; ++b)
#pragma unroll
            for (int m = 0; m < 4; ++m)
#pragma unroll
                for (int n = 0; n < 2; ++n) acc[a][b][m][n] = (f32x4){0.f, 0.f, 0.f, 0.f};
    bf16x8 At[4][2], B0[2][2], B1[2][2];
    const char* cA = (const char*)g.A + (long)S.arow(cur.pm) * (long)(K * 2); const char* cB = (const char*)g.Bt + (size_t)cur.pn * tstep;
    S.a_ready(cur);
    if constexpr (SP2) {
        PG8_STAGE(PG8_SB(0, 0), cB, voffB); PG8_STAGE(PG8_SB(0, 1), cB + hstep, voffB); PG8_STAGE(PG8_SA(0, 0), cA, voffA); PG8_STAGE(PG8_SA(0, 1), cA + hstep, voffA);
        if (wr == 1) PG8_BAR;
        PG8_WAIT_V(2); PG8_BAR;
        PG8_STAGE(PG8_SB(1, 0), cB + kstep, voffB); PG8_STAGE(PG8_SA(1, 0), cA + kstep, voffA); PG8_STAGE(PG8_SB(1, 1), cB + hstep + kstep, voffB);
        PG8_WAIT_V(6); PG8_BAR;
    } else {
        PG8_STAGE(PG8_SB(0, 0), cB, voffB); PG8_STAGE(PG8_SA(0, 0), cA, voffA); PG8_STAGE(PG8_SB(0, 1), cB + hstep, voffB); PG8_STAGE(PG8_SA(0, 1), cA + hstep, voffA);
        if (wr == 1) PG8_BAR;
        PG8_WAIT_V(4); PG8_BAR;
        PG8_STAGE(PG8_SB(1, 0), cB + kstep, voffB); PG8_STAGE(PG8_SA(1, 0), cA + kstep, voffA); PG8_STAGE(PG8_SB(1, 1), cB + hstep + kstep, voffB);
        PG8_WAIT_V(6); PG8_BAR;
    }
    for (;;) {
        const bool has_next = S.next(ui + 1, nxt);
        const char* nA = has_next ? (const char*)g.A + (long)S.arow(nxt.pm) * (long)(K * 2) : cA; const char* nB = has_next ? (const char*)g.Bt + (size_t)nxt.pn * tstep : cB;
#pragma unroll 1
        for (int t = 0; t < nt; t += 2) {
            const bool last = (t == nt - 2);
            const char* a1 = cA + (size_t)(t + 1) * kstep;
            const char* a2 = last ? nA : cA + (size_t)(t + 2) * kstep; const char* b2 = last ? nB : cB + (size_t)(t + 2) * kstep;
            const char* a3 = a2 + kstep; const char* b3 = b2 + kstep;
            if (last && has_next) S.a_ready(nxt);
            if constexpr (SP2) {
            PG8_LDB(B0, 0, 0); PG8_LDB(B1, 0, 1); PG8_SCHED; PG8_LDA(At, 0, 0); PG8_STAGE(PG8_SA(1, 1), a1 + hstep, voffA);
            PG8_WAIT_V(8); PG8_WAIT_L(0); PG8_BAR; PG8_MMA(0, 0, At, B0); PG8_MMA(0, 1, At, B1); PG8_BAR; PG8_SCHED;
            PG8_LDA(At, 0, 1); PG8_STAGE(PG8_SB(0, 0), b2, voffB); PG8_STAGE(PG8_SB(0, 1), b2 + hstep, voffB); PG8_STAGE(PG8_SA(0, 0), a2, voffA);
            PG8_WAIT_V(8); PG8_WAIT_L(0); PG8_BAR; PG8_MMA(1, 0, At, B0); PG8_MMA(1, 1, At, B1); PG8_BAR; PG8_SCHED;
            PG8_LDB(B0, 1, 0); PG8_LDB(B1, 1, 1); PG8_SCHED; PG8_LDA(At, 1, 0); PG8_STAGE(PG8_SA(0, 1), a2 + hstep, voffA);
            PG8_WAIT_V(8); PG8_WAIT_L(0); PG8_BAR; PG8_MMA(0, 0, At, B0); PG8_MMA(0, 1, At, B1); PG8_BAR; PG8_SCHED;
            PG8_LDA(At, 1, 1); PG8_STAGE(PG8_SB(1, 0), b3, voffB); PG8_STAGE(PG8_SB(1, 1), b3 + hstep, voffB); PG8_STAGE(PG8_SA(1, 0), a3, voffA);
            PG8_WAIT_V(8); PG8_WAIT_L(0); PG8_BAR; PG8_MMA(1, 0, At, B0); PG8_MMA(1, 1, At, B1); PG8_BAR; PG8_SCHED;
            } else {
            PG8_LDB(B0, 0, 0); PG8_SCHED; PG8_LDA(At, 0, 0); PG8_STAGE(PG8_SA(1, 1), a1 + hstep, voffA);
            PG8_WAIT_L(8); PG8_BAR; PG8_WAIT_L(0); PG8_MMA(0, 0, At, B0); PG8_BAR; PG8_SCHED;
            PG8_LDB(B1, 0, 1); PG8_STAGE(PG8_SB(0, 0), b2, voffB);
            PG8_BAR; PG8_WAIT_L(0); PG8_MMA(0, 1, At, B1); PG8_BAR;
            PG8_LDA(At, 0, 1); PG8_STAGE(PG8_SA(0, 0), a2, voffA);
            PG8_BAR; PG8_WAIT_L(0); PG8_MMA(1, 0, At, B0); PG8_BAR; PG8_SCHED;
            PG8_STAGE(PG8_SB(0, 1), b2 + hstep, voffB);
            PG8_WAIT_V(6); PG8_BAR; PG8_MMA(1, 1, At, B1); PG8_BAR;
            PG8_LDB(B0, 1, 0); PG8_SCHED; PG8_LDA(At, 1, 0); PG8_STAGE(PG8_SA(0, 1), a2 + hstep, voffA);
            PG8_WAIT_L(8); PG8_BAR; PG8_WAIT_L(0); PG8_MMA(0, 0, At, B0); PG8_BAR; PG8_SCHED;
            PG8_LDB(B1, 1, 1); PG8_STAGE(PG8_SB(1, 0), b3, voffB);
            PG8_BAR; PG8_WAIT_L(0); PG8_MMA(0, 1, At, B1); PG8_BAR;
            PG8_LDA(At, 1, 1); PG8_STAGE(PG8_SA(1, 0), a3, voffA);
            PG8_BAR; PG8_WAIT_L(0); PG8_MMA(1, 0, At, B0); PG8_BAR; PG8_SCHED;
            PG8_STAGE(PG8_SB(1, 1), b3 + hstep, voffB);
            PG8_WAIT_V(6); PG8_BAR; PG8_MMA(1, 1, At, B1); PG8_BAR;
            }
        }
        if constexpr (ALIGN_EPI) { if (wr == 0) PG8_BAR; }
        if constexpr (!Epi::AFTER_DRAIN) { E(acc, cur, wr, wc, fr, fq); S.done(cur); }
        if (!has_next) break;
#pragma unroll
        for (int a = 0; a < 2; ++a)
#pragma unroll
            for (int b = 0; b < 2; ++b)
#pragma unroll
                for (int m = 0; m < 4; ++m)
#pragma unroll
                    for (int n = 0; n < 2; ++n) acc[a][b][m][n] = (f32x4){0.f, 0.f, 0.f, 0.f};
        cur = nxt; cA = nA; cB = nB; ++ui;
        if constexpr (ALIGN_EPI) { if (wr == 1) PG8_BAR; }
    }
    PG8_WAIT_V(0);
    if constexpr (!ALIGN_EPI) { if (wr == 0) PG8_BAR; }
    PG8_BAR;
    if constexpr (Epi::AFTER_DRAIN) { E.fused(acc, cur, wr, wc, fr, fq, lds, wid, lane); S.done(cur); }
#undef PG8_SA
#undef PG8_SB
#undef PG8_STAGE
#undef PG8_LDA
#undef PG8_LDB
#undef PG8_MMA
#undef PG8_WAIT_V
#undef PG8_WAIT_L
#undef PG8_BAR
#undef PG8_SCHED
}
}

constexpr int NWV = 8;
constexpr int BATCH = 8, SEQ = 4096, DM = 1024, MTOK = BATCH * SEQ;
constexpr int PRW_LD = 2048, QKV_LD = 2304, N1 = 6400;
constexpr int RWC = 1824, KLORA = 384, NLORA = 1536, DFF = 3072;
constexpr float NEPS = 1e-6f;
constexpr float LOG2E = 1.4426950408889634f;
constexpr size_t HM = 512 * 1024;
constexpr size_t OFF_W1T = 0, OFF_WLORA = 25 * HM, OFF_WA = 28 * HM, OFF_WB = 30 * HM, OFF_WOUT = 31 * HM, OFF_WUP = 35 * HM, OFF_WDN = 59 * HM, OFF_WPG = 71 * HM, OFF_WPLE = 75 * HM;
constexpr size_t OFF_RS0 = 76 * HM, OFF_RSPA = 77 * HM, OFF_RSPB = 81 * HM, OFF_RK = 85 * HM, OFF_ALSE = 87 * HM, OFF_PB = 90 * HM, OFF_XB = 122 * HM, OFF_BIG = 250 * HM;
constexpr size_t OFF_PRW = OFF_BIG, OFF_QKV = 506 * HM, OFF_LW = 794 * HM, OFF_AA = 858 * HM, OFF_GG = 922 * HM;
constexpr size_t OFF_ALORA = OFF_XB, OFF_YRAW = OFF_XB, OFF_YA = OFF_LW, OFF_YB = OFF_AA, OFF_MERGED = OFF_PRW, OFF_U = OFF_BIG, OFF_HMID = 634 * HM, OFF_PL = OFF_BIG;
constexpr size_t OFF_UA = 378 * HM, OFF_UB = 392 * HM;
constexpr size_t OFF_CTL = 1018 * HM, CTL_BYTES = 65536;
constexpr size_t WS_NEED = OFF_CTL + CTL_BYTES;
constexpr int LDS_BYTES = 147456;
constexpr int N_PHASES = 15;
constexpr int SCAN_BLOCKS = 128;

#define LAS __attribute__((address_space(3)))
typedef unsigned short bf16_t;
typedef float f32x4 __attribute__((ext_vector_type(4)));
typedef unsigned u32x4 __attribute__((ext_vector_type(4)));
typedef unsigned u32x2 __attribute__((ext_vector_type(2)));
typedef short bf16x8 __attribute__((ext_vector_type(8)));
typedef float f32x16 __attribute__((ext_vector_type(16)));
#define LDS_WAIT() asm volatile("s_waitcnt lgkmcnt(0)" ::: "memory")

__device__ __forceinline__ float bf2f(unsigned h) { return __uint_as_float(h << 16); }
__device__ __forceinline__ float bflo(unsigned w) { return __uint_as_float(w << 16); }
__device__ __forceinline__ float bfhi(unsigned w) { return __uint_as_float(w & 0xffff0000u); }
__device__ __forceinline__ unsigned f2bf(float f) { unsigned u = __float_as_uint(f); return (u + 0x7fffu + ((u >> 16) & 1u)) >> 16; }
__device__ __forceinline__ unsigned pk2(float lo, float hi) { return f2bf(lo) | (f2bf(hi) << 16); }
__device__ __forceinline__ float sigmoidf_(float x) { return __builtin_amdgcn_rcpf(1.0f + __expf(-x)); }
__device__ __forceinline__ float dpp_add(float x, const int ctrl_sel) {
    int t;
    if (ctrl_sel == 0) t = __builtin_amdgcn_update_dpp(0, __float_as_int(x), 0xB1, 0xf, 0xf, true);
    else if (ctrl_sel == 1) t = __builtin_amdgcn_update_dpp(0, __float_as_int(x), 0x4E, 0xf, 0xf, true);
    else if (ctrl_sel == 2) t = __builtin_amdgcn_update_dpp(0, __float_as_int(x), 0x141, 0xf, 0xf, true);
    else t = __builtin_amdgcn_update_dpp(0, __float_as_int(x), 0x140, 0xf, 0xf, true);
    return x + __int_as_float(t);
}
__device__ __forceinline__ float allsum16(float x) { x = dpp_add(x, 0); x = dpp_add(x, 1); x = dpp_add(x, 2); x = dpp_add(x, 3); return x; }
__device__ __forceinline__ float allsum8(float x) { x = dpp_add(x, 0); x = dpp_add(x, 1); x = dpp_add(x, 2); return x; }
__device__ __forceinline__ float wave_sum(float v) {
    v = allsum16(v);
    const float s0 = __int_as_float(__builtin_amdgcn_readlane(__float_as_int(v), 0)), s1 = __int_as_float(__builtin_amdgcn_readlane(__float_as_int(v), 16));
    const float s2 = __int_as_float(__builtin_amdgcn_readlane(__float_as_int(v), 32)), s3 = __int_as_float(__builtin_amdgcn_readlane(__float_as_int(v), 48));
    return (s0 + s1) + (s2 + s3);
}
__device__ __forceinline__ void unpack8(const u32x4 w, float (&f)[8]) { f[0] = bflo(w.x); f[1] = bfhi(w.x); f[2] = bflo(w.y); f[3] = bfhi(w.y); f[4] = bflo(w.z); f[5] = bfhi(w.z); f[6] = bflo(w.w); f[7] = bfhi(w.w); }
__device__ __forceinline__ u32x4 pack8(const float (&f)[8]) { u32x4 w; w.x = pk2(f[0], f[1]); w.y = pk2(f[2], f[3]); w.z = pk2(f[4], f[5]); w.w = pk2(f[6], f[7]); return w; }

__device__ __forceinline__ float gelu_tanh(float x) { const float z = x * (-2.3022082f + (-0.1029432f) * (x * x)); return x * __builtin_amdgcn_rcpf(1.0f + __builtin_amdgcn_exp2f(z)); }
struct Args { const float* in[29]; float* out; unsigned char* ws; int ph_lo, ph_hi; };

#define EPI_ROWS(...) _Pragma("unroll") for (int ai = 0; ai < 2; ++ai) _Pragma("unroll") for (int m = 0; m < 4; ++m) { const int row = row0 + ai * 128 + m * 16; __VA_ARGS__ asm volatile("" ::: "memory"); }
typedef float f32x2c_t __attribute__((ext_vector_type(2))); typedef __bf16 bf16x2c_t __attribute__((ext_vector_type(2)));
__device__ __forceinline__ unsigned cvtpk_c(float lo, float hi) { const f32x2c_t v = {lo, hi}; const bf16x2c_t b = __builtin_convertvector(v, bf16x2c_t); return __builtin_bit_cast(unsigned, b); }
__device__ __forceinline__ u32x4 pack_acc8(const f32x4 v0, const f32x4 v1) { u32x4 w; w.x = cvtpk_c(v0[0], v0[1]); w.y = cvtpk_c(v0[2], v0[3]); w.z = cvtpk_c(v1[0], v1[1]); w.w = cvtpk_c(v1[2], v1[3]); return w; }
__device__ __forceinline__ float rstd16(const float* rsp, int row) {
    const f32x4* p = (const f32x4*)(rsp + (size_t)row * 16); const f32x4 a = p[0], b = p[1], c = p[2], d = p[3];
    const float s = (((a[0] + a[1]) + (a[2] + a[3])) + ((b[0] + b[1]) + (b[2] + b[3]))) + (((c[0] + c[1]) + (c[2] + c[3])) + ((d[0] + d[1]) + (d[2] + d[3])));
    return rsqrtf(s * (1.0f / DM) + NEPS);
}

struct EpiG1 {
    static constexpr bool PERM = true, AFTER_DRAIN = false;
    bf16_t* prw; bf16_t* qkv; bf16_t* gate; const float* rs0; const float* bg;
    __device__ __forceinline__ void operator()(const f32x4 (&acc)[2][2][4][2], const pg8::Unit& u, int wr, int wc, int fr, int fq) const {
        const int row0 = u.pm * 256 + wr * 64 + fr, ct = wc * 32 + 8 * fq;
        bf16_t* base; int ld, coff; const bool isg = u.pn >= 17;
        if (u.pn < 8) { base = prw; ld = PRW_LD; coff = u.pn * 256; } else if (u.pn < 17) { base = qkv; ld = QKV_LD; coff = (u.pn - 8) * 256; } else { base = gate; ld = 2048; coff = (u.pn - 17) * 256; }
        f32x4 bv[2][2];
#pragma unroll
        for (int bj = 0; bj < 2; ++bj)
#pragma unroll
            for (int n = 0; n < 2; ++n) bv[bj][n] = isg ? *(const f32x4*)(bg + coff + ct + bj * 128 + 4 * n) : (f32x4){0.f, 0.f, 0.f, 0.f};
        EPI_ROWS(
            const float rs = rs0[row]; bf16_t* rp = base + (size_t)row * ld + coff + ct;
            _Pragma("unroll") for (int bj = 0; bj < 2; ++bj) { f32x4 v0 = acc[ai][bj][m][0] * rs, v1 = acc[ai][bj][m][1] * rs;
                if (isg) { v0 = v0 + bv[bj][0]; v1 = v1 + bv[bj][1];
                    _Pragma("unroll") for (int e = 0; e < 4; ++e) { v0[e] = sigmoidf_(v0[e]); v1[e] = sigmoidf_(v1[e]); } }
                __builtin_nontemporal_store(pack_acc8(v0, v1), (u32x4*)(rp + bj * 128)); }
        )
    }
};
__device__ __forceinline__ float lwf(float x) { const float z = -x; const float sp = fmaxf(z, 0.f) + __logf(1.0f + __expf(-fabsf(z))); return -__expf(-sp - 0.5f); }
struct EpiLora {
    static constexpr bool PERM = true, AFTER_DRAIN = false;
    bf16_t* lw; bf16_t* gg; const float* w0; const float* a0;
    __device__ __forceinline__ void operator()(const f32x4 (&acc)[2][2][4][2], const pg8::Unit& u, int wr, int wc, int fr, int fq) const {
        const int row0 = u.pm * 256 + wr * 64 + fr, ct = wc * 32 + 8 * fq; const bool first = u.pn < 4;
        bf16_t* base = (first ? lw + u.pn * 256 : gg + (u.pn - 4) * 256) + ct; const int ld = first ? 1024 : 512;
        const float* bsrc = (u.pn < 2 ? w0 + u.pn * 256 : a0 + (u.pn & 1) * 256) + ct;
        f32x4 bv[2][2];
#pragma unroll
        for (int bj = 0; bj < 2; ++bj)
#pragma unroll
            for (int n = 0; n < 2; ++n) bv[bj][n] = first ? *(const f32x4*)(bsrc + bj * 128 + 4 * n) : (f32x4){0.f, 0.f, 0.f, 0.f};
        EPI_ROWS(
            bf16_t* rp = base + (size_t)row * ld;
            _Pragma("unroll") for (int bj = 0; bj < 2; ++bj) { f32x4 v0 = acc[ai][bj][m][0], v1 = acc[ai][bj][m][1];
                if (first) { v0 = v0 + bv[bj][0]; v1 = v1 + bv[bj][1];
                    _Pragma("unroll") for (int e = 0; e < 4; ++e) { v0[e] = sigmoidf_(v0[e]); v1[e] = sigmoidf_(v1[e]); } }
                *(u32x4*)(rp + bj * 128) = pack_acc8(v0, v1); }
        )
    }
};
template <int WHICH> struct EpiBranch {
    static constexpr bool PERM = true, AFTER_DRAIN = false;
    bf16_t* merged; const bf16_t* gate;
    __device__ __forceinline__ void operator()(const f32x4 (&acc)[2][2][4][2], const pg8::Unit& u, int wr, int wc, int fr, int fq) const {
        const int row0 = u.pm * 256 + wr * 64 + fr, ct = u.pn * 256 + wc * 32 + 8 * fq;
        EPI_ROWS(
            bf16_t* rp = merged + (size_t)row * DM + ct; const bf16_t* gp = gate + (size_t)row * 2048 + WHICH * 1024 + ct;
            _Pragma("unroll") for (int bj = 0; bj < 2; ++bj) { float gv[8]; unpack8(*(const u32x4*)(gp + bj * 128), gv);
                f32x4 v0 = acc[ai][bj][m][0], v1 = acc[ai][bj][m][1];
                _Pragma("unroll") for (int e = 0; e < 4; ++e) { v0[e] *= gv[e]; v1[e] *= gv[4 + e]; }
                if (WHICH == 1) { float tv[8]; unpack8(*(const u32x4*)(rp + bj * 128), tv);
                    _Pragma("unroll") for (int e = 0; e < 4; ++e) { v0[e] += tv[e]; v1[e] += tv[4 + e]; } }
                *(u32x4*)(rp + bj * 128) = pack_acc8(v0, v1); }
        )
    }
};
template <int MODE, bool RES_BF16> struct EpiRes {
    static constexpr bool PERM = true, AFTER_DRAIN = false;
    const float* res; const bf16_t* resb; bf16_t* xb; float* rsp_out; const float* rsp_in; const bf16_t* pl;
    __device__ __forceinline__ void operator()(const f32x4 (&acc)[2][2][4][2], const pg8::Unit& u, int wr, int wc, int fr, int fq) const {
        const int row0 = u.pm * 256 + wr * 64 + fr, ct = u.pn * 256 + wc * 32 + 8 * fq;
        EPI_ROWS(
            const size_t ro = (size_t)row * DM + ct; float q = 0.f; float rs = 1.f; if (MODE == 1) rs = rstd16(rsp_in, row);
            _Pragma("unroll") for (int bj = 0; bj < 2; ++bj) { f32x4 v0 = acc[ai][bj][m][0], v1 = acc[ai][bj][m][1];
                if (MODE == 1) { float pv[8]; unpack8(*(const u32x4*)(pl + ro + bj * 128), pv);
                    _Pragma("unroll") for (int e = 0; e < 4; ++e) { v0[e] = sigmoidf_(v0[e] * rs) * pv[e]; v1[e] = sigmoidf_(v1[e] * rs) * pv[4 + e]; } }
                if (RES_BF16) { float rv[8]; unpack8(*(const u32x4*)(resb + ro + bj * 128), rv);
                    _Pragma("unroll") for (int e = 0; e < 4; ++e) { v0[e] += rv[e]; v1[e] += rv[4 + e]; } }
                else { const f32x4 r0 = *(const f32x4*)(res + ro + bj * 128), r1 = *(const f32x4*)(res + ro + bj * 128 + 4); v0 = v0 + r0; v1 = v1 + r1; }
                *(u32x4*)(xb + ro + bj * 128) = pack_acc8(v0, v1);
                q += ((v0[0] * v0[0] + v0[1] * v0[1]) + (v0[2] * v0[2] + v0[3] * v0[3])) + ((v1[0] * v1[0] + v1[1] * v1[1]) + (v1[2] * v1[2] + v1[3] * v1[3])); }
            q += __shfl_xor(q, 16); q += __shfl_xor(q, 32);
            if (fq == 0) rsp_out[(size_t)row * 16 + u.pn * 4 + wc] = q;
        )
    }
};
struct EpiUp {
    static constexpr bool PERM = true, AFTER_DRAIN = false;
    bf16_t* U; const float* rsp; int rowbase;
    __device__ __forceinline__ void operator()(const f32x4 (&acc)[2][2][4][2], const pg8::Unit& u, int wr, int wc, int fr, int fq) const {
        const int row0 = u.pm * 256 + wr * 64 + fr, ct = u.pn * 256 + wc * 32 + 8 * fq;
        EPI_ROWS(
            const float rs = rstd16(rsp, rowbase + row); bf16_t* rp = U + (size_t)row * 6144 + ct;
            _Pragma("unroll") for (int bj = 0; bj < 2; ++bj) *(u32x4*)(rp + bj * 128) = pack_acc8(acc[ai][bj][m][0] * rs, acc[ai][bj][m][1] * rs);
        )
    }
};
struct UpOrder : pg8::StaticOrder {
    __device__ __forceinline__ long arow(int pm) const { return (long)(pm / 17) * SEQ + 254 * (pm % 17) - 2; }
};
template <int CTRL> __device__ __forceinline__ float dppf(float x) { return __int_as_float(__builtin_amdgcn_update_dpp(0, __float_as_int(x), CTRL, 0xf, 0xf, true)); }
struct EpiUpGlu {
    static constexpr bool PERM = true, AFTER_DRAIN = false;
    bf16_t* hmid; const float* rsp; const float* cw; const float* cb; LAS float* xch; float* ua; float* ub;
    __device__ __forceinline__ void operator()(f32x4 (&acc)[2][2][4][2], const pg8::Unit& u, int wr, int wc, int fr, int fq) const {
        const int rowt = u.pm * 256;
        const int rho0 = wr * 64 + fr, ct = wc * 32 + 8 * fq;
#pragma unroll
        for (int ai = 0; ai < 2; ++ai)
#pragma unroll
            for (int m = 0; m < 4; ++m) { const float rs = rstd16(rsp, rowt + rho0 + ai * 128 + m * 16);
#pragma unroll
                for (int bj = 0; bj < 2; ++bj) { acc[ai][bj][m][0] = acc[ai][bj][m][0] * rs; acc[ai][bj][m][1] = acc[ai][bj][m][1] * rs; }
                asm volatile("" : "+v"(acc[ai][0][m][0]), "+v"(acc[ai][0][m][1]), "+v"(acc[ai][1][m][0]), "+v"(acc[ai][1][m][1]) :: "memory"); __builtin_amdgcn_sched_barrier(0); }
        if (fr >= 14) {
#pragma unroll
            for (int ai = 0; ai < 2; ++ai)
#pragma unroll
                for (int bj = 0; bj < 2; ++bj)
#pragma unroll
                    for (int n = 0; n < 2; ++n) *(LAS f32x4*)(xch + ((ai * 2 + wr) * 2 + (fr - 14)) * 256 + bj * 128 + ct + 4 * n) = acc[ai][bj][3][n];
            if (wr == 1) {
                float* ubp = ub + ((size_t)u.pm * 2 + (fr - 14)) * 6144 + u.pn * 256 + ct;
                *(f32x4*)(ubp) = acc[1][0][3][0]; *(f32x4*)(ubp + 4) = acc[1][0][3][1]; *(f32x4*)(ubp + 128) = acc[1][1][3][0]; *(f32x4*)(ubp + 132) = acc[1][1][3][1];
            }
        }
        if (wr == 0 && fr < 2) {
            float* uap = ua + ((size_t)u.pm * 2 + fr) * 6144 + u.pn * 256 + ct;
            *(f32x4*)(uap) = acc[0][0][0][0]; *(f32x4*)(uap + 4) = acc[0][0][0][1]; *(f32x4*)(uap + 128) = acc[0][1][0][0]; *(f32x4*)(uap + 132) = acc[0][1][0][1];
        }
        __builtin_amdgcn_sched_barrier(0);
        asm volatile("s_waitcnt lgkmcnt(0)" ::: "memory"); __builtin_amdgcn_s_barrier(); asm volatile("" ::: "memory");
#pragma unroll
        for (int n = 0; n < 2; ++n) {
#pragma unroll
            for (int bj = 0; bj < 2; ++bj) {
                const int col = bj * 3072 + u.pn * 128 + ct + 4 * n;
                const f32x4 c0 = *(const f32x4*)(cw + col), c1 = *(const f32x4*)(cw + 6144 + col), c2 = *(const f32x4*)(cw + 2 * 6144 + col), cbv = *(const f32x4*)(cb + col);
#pragma unroll
                for (int ai = 0; ai < 2; ++ai) {
                    const int seg = ai * 2 + wr;
                    f32x4 X = {0.f, 0.f, 0.f, 0.f};
                    if (seg > 0) X = *(const LAS f32x4*)(xch + ((seg - 1) * 2 + (fr & 1)) * 256 + bj * 128 + ct + 4 * n);
#pragma unroll
                    for (int m = 3; m >= 0; --m) {
                        f32x4 v = acc[ai][bj][m][n]; f32x4 vp = (m > 0) ? acc[ai][bj][m > 0 ? m - 1 : 0][n] : X; f32x4 o;
                        asm volatile("" : "+v"(v), "+v"(vp));
#pragma unroll
                        for (int e = 0; e < 4; ++e) {
                            const float p1 = __int_as_float(__builtin_amdgcn_update_dpp(__float_as_int(dppf<0x121>(vp[e])), __float_as_int(v[e]), 0x111, 0xf, 0xf, false));
                            const float p2 = __int_as_float(__builtin_amdgcn_update_dpp(__float_as_int(dppf<0x122>(vp[e])), __float_as_int(v[e]), 0x112, 0xf, 0xf, false));
                            o[e] = cbv[e] + c0[e] * v[e] + c1[e] * p1 + c2[e] * p2; }
                        asm volatile("" : "+v"(o));
                        acc[ai][bj][m][n] = o;
                        __builtin_amdgcn_sched_barrier(0);
                    }
                }
            }
#pragma unroll
            for (int ai = 0; ai < 2; ++ai)
#pragma unroll
                for (int m = 0; m < 4; ++m) { f32x4 gv = acc[ai][0][m][n]; const f32x4 vv = acc[ai][1][m][n];
#pragma unroll
                    for (int e = 0; e < 4; ++e) gv[e] = gelu_tanh(gv[e]) * vv[e];
                    asm volatile("" : "+v"(gv));
                    acc[ai][0][m][n] = gv; __builtin_amdgcn_sched_barrier(0); }
        }
#pragma unroll
        for (int ai = 0; ai < 2; ++ai)
#pragma unroll
            for (int m = 0; m < 4; ++m) { const int rho = rho0 + ai * 128 + m * 16;
                if (rho >= 2) __builtin_nontemporal_store(pack_acc8(acc[ai][0][m][0], acc[ai][0][m][1]), (u32x4*)(hmid + ((size_t)rowt + rho) * DFF + u.pn * 128 + ct));
                asm volatile("" ::: "memory"); __builtin_amdgcn_sched_barrier(0); }
    }
};
struct EpiPlain {
    static constexpr bool PERM = true, AFTER_DRAIN = false;
    bf16_t* O; int ld;
    __device__ __forceinline__ void operator()(const f32x4 (&acc)[2][2][4][2], const pg8::Unit& u, int wr, int wc, int fr, int fq) const {
        const int row0 = u.pm * 256 + wr * 64 + fr, ct = u.pn * 256 + wc * 32 + 8 * fq;
        EPI_ROWS(
            bf16_t* rp = O + (size_t)row * ld + ct;
            _Pragma("unroll") for (int bj = 0; bj < 2; ++bj) *(u32x4*)(rp + bj * 128) = pack_acc8(acc[ai][bj][m][0], acc[ai][bj][m][1]);
        )
    }
};

__device__ __forceinline__ void tr_item(const float* __restrict__ W, int ldw, int k0, int n0, const float* __restrict__ g, bf16_t* WT, int ldd, int drow0, LAS float* scr, int lane) {
    f32x4 wv[8];
#pragma unroll
    for (int i = 0; i < 8; ++i) wv[i] = __builtin_nontemporal_load((const f32x4*)(W + (size_t)(k0 + 8 * i + (lane >> 3)) * ldw + n0 + 4 * (lane & 7)));
#pragma unroll
    for (int i = 0; i < 8; ++i) { const int kk = 8 * i + (lane >> 3); f32x4 v = wv[i]; if (g) v = v * g[k0 + kk];
        LAS float* sp = scr + kk * 33 + 4 * (lane & 7); sp[0] = v[0]; sp[1] = v[1]; sp[2] = v[2]; sp[3] = v[3]; }
    LDS_WAIT();
    const int c = lane & 7;
#pragma unroll
    for (int j = 0; j < 4; ++j) { const int n = (lane >> 3) + 8 * j; const LAS float* s = scr + (8 * c) * 33 + n;
        u32x4 o; o.x = pk2(s[0 * 33], s[1 * 33]); o.y = pk2(s[2 * 33], s[3 * 33]); o.z = pk2(s[4 * 33], s[5 * 33]); o.w = pk2(s[6 * 33], s[7 * 33]);
        *(u32x4*)(WT + (size_t)(drow0 + n) * ldd + k0 + 8 * c) = o; }
    LDS_WAIT();
}
__device__ __forceinline__ void tr_matrix_item(const float* W, int K, int N, const float* g, bf16_t* WT, int r, LAS float* scr, int lane) {
    const int nblk = N / 32, kb = r / nblk, nb = r % nblk; tr_item(W, N, 64 * kb, 32 * nb, g, WT, K, 32 * nb, scr, lane);
}

__device__ __forceinline__ int crow(int r, int hi) { return (r & 3) + 8 * (r >> 2) + 4 * hi; }
typedef short v4i16_t __attribute__((ext_vector_type(4)));
__device__ __forceinline__ void attn_unit(bf16_t* QKV, float* ALSE, int unit, int lane, LAS unsigned char* vlds  , int do_store = 1) {
    const int g = unit >> 12, rem = unit & 4095, b = rem >> 9, hg = (rem >> 7) & 3, tile = rem & 127;
    const int d = (g == 0) ? 1 : ((g == 1) ? 4 : 16), tps = 128 / d, r = tile / tps, qt = tile % tps, i0 = 32 * qt;
    const int h = g * 4 + hg;
    const float slope = exp2f(-8.0f * (float)(h + 1) / 12.0f);
    const float c1 = 0.125f * LOG2E, c2 = slope * (float)d * LOG2E;
    const int qq = lane & 31, hi = lane >> 5;
    const size_t rowq = (size_t)b * SEQ + r + (size_t)d * (i0 + qq);
    bf16_t* qptr = QKV + rowq * QKV_LD + h * 64;
    bf16x8 qf[4];
#pragma unroll
    for (int ds = 0; ds < 4; ++ds) qf[ds] = *(const bf16x8*)(qptr + 16 * ds + 8 * hi);
    const bf16_t* Kb = QKV + ((size_t)b * SEQ + r) * QKV_LD + 768 + h * 64;
    const bf16_t* Vb = QKV + ((size_t)b * SEQ + r) * QKV_LD + 1536 + h * 64;
    float m_run = -1e30f, l_run = 0.f;
    f32x16 o0, o1;
#pragma unroll
    for (int i = 0; i < 16; ++i) { o0[i] = 0.f; o1[i] = 0.f; }
    for (int kt = 0; kt < 5; ++kt) {
        const int kb = i0 - 128 + 32 * kt;
        if (kb + 31 < 0) continue;
        const int ik = kb + qq, ikc = ik < 0 ? 0 : ik;
        u32x4 vreg[4];
#pragma unroll
        for (int i = 0; i < 4; ++i) { int key = kb + (lane >> 3) + 8 * i; key = key < 0 ? 0 : key; vreg[i] = *(const u32x4*)(Vb + (size_t)d * key * QKV_LD + (lane & 7) * 8); }
        const bf16_t* kp = Kb + (size_t)d * ikc * QKV_LD;
        f32x16 s;
#pragma unroll
        for (int i = 0; i < 16; ++i) s[i] = 0.f;
#pragma unroll
        for (int ds = 0; ds < 4; ++ds) { const bf16x8 kf = *(const bf16x8*)(kp + 16 * ds + 8 * hi); s = __builtin_amdgcn_mfma_f32_32x32x16_bf16(kf, qf[ds], s, 0, 0, 0); }
        float p[16]; float tmax = -1e30f;
#pragma unroll
        for (int rr = 0; rr < 16; ++rr) { const int kap = crow(rr, hi); const int st = qq + 128 - 32 * kt - kap; const bool valid = (st >= 0) && (st <= 128) && (kb + kap >= 0);
            p[rr] = valid ? (s[rr] * c1 - c2 * (float)st) : -1e30f; tmax = fmaxf(tmax, p[rr]); }
        tmax = fmaxf(tmax, __shfl_xor(tmax, 32));
        const float m_new = fmaxf(m_run, tmax), alpha = exp2f(m_run - m_new);
        float psum = 0.f;
#pragma unroll
        for (int rr = 0; rr < 16; ++rr) { p[rr] = (p[rr] > -1e29f) ? exp2f(p[rr] - m_new) : 0.f; psum += p[rr]; }
        psum += __shfl_xor(psum, 32);
        l_run = l_run * alpha + psum; m_run = m_new;
#pragma unroll
        for (int i = 0; i < 16; ++i) { o0[i] *= alpha; o1[i] *= alpha; }
#pragma unroll
        for (int i = 0; i < 4; ++i) *(LAS u32x4*)(vlds + ((lane >> 3) + 8 * i) * 128 + (lane & 7) * 16) = vreg[i];
        LDS_WAIT();
#pragma unroll
        for (int j = 0; j < 2; ++j) {
            u32x4 pw; pw.x = pk2(p[8 * j + 0], p[8 * j + 1]); pw.y = pk2(p[8 * j + 2], p[8 * j + 3]); pw.z = pk2(p[8 * j + 4], p[8 * j + 5]); pw.w = pk2(p[8 * j + 6], p[8 * j + 7]);
            const bf16x8 pf = __builtin_bit_cast(bf16x8, pw);
            const int q_ = (lane & 15) >> 2, p_ = lane & 3, blk = (lane >> 4) & 1;
            LAS unsigned char* rb = vlds + (16 * j + 4 * hi + q_) * 128 + blk * 32 + 8 * p_;
            const v4i16_t a0 = __builtin_amdgcn_ds_read_tr16_b64_v4i16((LAS v4i16_t*)(rb)), a1 = __builtin_amdgcn_ds_read_tr16_b64_v4i16((LAS v4i16_t*)(rb + 8 * 128));
            const v4i16_t b0 = __builtin_amdgcn_ds_read_tr16_b64_v4i16((LAS v4i16_t*)(rb + 64)), b1 = __builtin_amdgcn_ds_read_tr16_b64_v4i16((LAS v4i16_t*)(rb + 8 * 128 + 64));
            const bf16x8 v0 = {a0[0], a0[1], a0[2], a0[3], a1[0], a1[1], a1[2], a1[3]}, v1 = {b0[0], b0[1], b0[2], b0[3], b1[0], b1[1], b1[2], b1[3]};
            o0 = __builtin_amdgcn_mfma_f32_32x32x16_bf16(v0, pf, o0, 0, 0, 0);
            o1 = __builtin_amdgcn_mfma_f32_32x32x16_bf16(v1, pf, o1, 0, 0, 0);
        }
        LDS_WAIT();
    }
    const float inv = 1.0f / l_run;
    if (do_store) {
#pragma unroll
    for (int q4 = 0; q4 < 4; ++q4) {
        u32x2 w0, w1;
        w0.x = pk2(o0[4 * q4] * inv, o0[4 * q4 + 1] * inv); w0.y = pk2(o0[4 * q4 + 2] * inv, o0[4 * q4 + 3] * inv);
        w1.x = pk2(o1[4 * q4] * inv, o1[4 * q4 + 1] * inv); w1.y = pk2(o1[4 * q4 + 2] * inv, o1[4 * q4 + 3] * inv);
        *(u32x2*)(qptr + 8 * q4 + 4 * hi) = w0; *(u32x2*)(qptr + 32 + 8 * q4 + 4 * hi) = w1;
    }
    if (hi == 0) ALSE[((size_t)g * MTOK + rowq) * 4 + hg] = m_run + log2f(l_run);
    }
}

constexpr int SC_NB = 16;
typedef float f32x2 __attribute__((ext_vector_type(2)));
__device__ __forceinline__ void scan_block(const Args& a, LAS unsigned char* ldsb, int bx, int tid) {
    LAS float* OP = (LAS float*)ldsb;
    LAS float* VV = OP + 2 * SC_NB * 320;
    LAS float* YP = VV + 2 * SC_NB * 16;
    const int lane = tid & 63, w = tid >> 6;
    const int bh = (bx & 7) * 8 + ((bx >> 3) >> 2), qtr = (bx >> 3) & 3, b = bh >> 3, h = bh & 7;
    const bf16_t* PRW = (const bf16_t*)(a.ws + OFF_PRW); const bf16_t* LWA = (const bf16_t*)(a.ws + OFF_LW);
    float* YRAW = (float*)(a.ws + OFF_YRAW);
    const size_t mb = (size_t)b * SEQ;
    const bool is_scan = w < 4;
    const int rl = (w & 3) * 4 + (lane >> 4), j = lane & 15;
    f32x2 S01 = {0.f, 0.f}, S23 = {0.f, 0.f};
    const int pt = tid & 255, s_ = pt >> 4, k4 = (pt & 15) * 4, hc4 = h * 64 + k4;
    const f32x4 kk_c = *(const f32x4*)(a.in[10] + hc4), ka_c = *(const f32x4*)(a.in[11] + hc4), rk_c = *(const f32x4*)(a.in[12] + hc4);
    const f32x4 mu_r = *(const f32x4*)(a.in[4] + hc4), mu_k = *(const f32x4*)(a.in[4] + 512 + hc4), mu_v = *(const f32x4*)(a.in[4] + 1024 + hc4);
    float* RKB = (float*)(a.ws + OFF_RSPB);
    const float* KN = (const float*)(a.ws + OFF_RK);
    u32x2 lr[2][2], lk[2][2], lv[2][2], lw_[2], la_[2]; float kn_[2];
#define SC_LOAD(SET, nb) do { const int t = (nb) * SC_NB + s_; const bf16_t* row = PRW + (mb + t) * PRW_LD + hc4; const bf16_t* prw_ = t > 0 ? row - PRW_LD : row; \
        lr[SET][0] = *(const u32x2*)row; lr[SET][1] = *(const u32x2*)prw_; lk[SET][0] = *(const u32x2*)(row + 512); lk[SET][1] = *(const u32x2*)(prw_ + 512); \
        lv[SET][0] = *(const u32x2*)(row + 1024); lv[SET][1] = *(const u32x2*)(prw_ + 1024); \
        lw_[SET] = *(const u32x2*)(LWA + (mb + t) * 1024 + hc4); la_[SET] = *(const u32x2*)(LWA + (mb + t) * 1024 + 512 + hc4); kn_[SET] = KN[(mb + t) * 8 + h]; } while (0)
#define SC_U4(w, f) do { f[0] = bflo((w).x); f[1] = bfhi((w).x); f[2] = bflo((w).y); f[3] = bfhi((w).y); } while (0)
#define SC_PREP(SET, nb) do { LAS float* opb = OP + ((nb) & 1) * (SC_NB * 320) + s_ * 320 + k4; LAS float* vvb = VV + ((nb) & 1) * (SC_NB * 16) + s_ * 16; \
        const float tm = ((nb) * SC_NB + s_) > 0 ? 1.f : 0.f; \
        f32x4 cr, pr_, ck, pk_, cv, pv_, sw, sa_; SC_U4(lr[SET][0], cr); SC_U4(lr[SET][1], pr_); SC_U4(lk[SET][0], ck); SC_U4(lk[SET][1], pk_); SC_U4(lv[SET][0], cv); SC_U4(lv[SET][1], pv_); SC_U4(lw_[SET], sw); SC_U4(la_[SET], sa_); \
        const f32x4 r_ = cr + (pr_ * tm - cr) * mu_r, k_ = ck + (pk_ * tm - ck) * mu_k, v_ = cv + (pv_ * tm - cv) * mu_v; \
        f32x4 dec; _Pragma("unroll") for (int e = 0; e < 4; ++e) dec[e] = __expf(-0.6065306597126334f * sw[e]); \
        const f32x4 kk = k_ * kk_c * kn_[SET]; const f32x4 kp = k_ * ((sa_ - 1.0f) * ka_c + 1.0f); \
        *(LAS f32x4*)(opb) = dec; *(LAS f32x4*)(opb + 64) = -kk; *(LAS f32x4*)(opb + 128) = kk * sa_; *(LAS f32x4*)(opb + 192) = kp; *(LAS f32x4*)(opb + 256) = r_; \
        if (((pt & 15) >> 2) == qtr) *(LAS f32x4*)(vvb + (pt & 3) * 4) = v_; \
        { const f32x4 q4 = r_ * kp * rk_c; float rk = (q4[0] + q4[1]) + (q4[2] + q4[3]); rk = allsum16(rk); \
          if ((s_ & 3) == qtr && (pt & 15) == 0) RKB[(mb + (nb) * SC_NB + s_) * 8 + h] = rk; } } while (0)
#define SC_YRED(nb) do { const LAS float* ypb = YP + ((nb) & 1) * (SC_NB * 256); const int s = pt >> 4, r = pt & 15; \
        const LAS f32x4* q4 = (const LAS f32x4*)(ypb + s * 256 + r * 16); const f32x4 y0 = q4[0], y1 = q4[1], y2 = q4[2], y3 = q4[3]; \
        const float ysum = (((y0[0] + y0[1]) + (y0[2] + y0[3])) + ((y1[0] + y1[1]) + (y1[2] + y1[3]))) + (((y2[0] + y2[1]) + (y2[2] + y2[3])) + ((y3[0] + y3[1]) + (y3[2] + y3[3]))); \
        YRAW[(mb + (nb) * SC_NB + s) * 512 + h * 64 + 16 * qtr + r] = ysum; } while (0)
    constexpr int NBATCH = SEQ / SC_NB;
#if (PROBE_MASK >> 15) & 1
    int nrep_ = 2; asm volatile("" : "+s"(nrep_));
#pragma unroll 1
    for (int rep_ = 0; rep_ < nrep_; ++rep_) {
    S01 = (f32x2){0.f, 0.f}; S23 = (f32x2){0.f, 0.f};
#else
    {
#endif
    if (!is_scan) { SC_LOAD(0, 0); SC_LOAD(1, 1); SC_PREP(0, 0); SC_LOAD(0, 2); }
    __syncthreads();
    if (is_scan) __builtin_amdgcn_s_setprio(3);
#pragma unroll 1
    for (int it2 = 0; it2 < NBATCH; it2 += 2) {
#pragma unroll
        for (int par = 0; par < 2; ++par) {
            const int it = it2 + par;
            if (is_scan) {
                const LAS float* opb = OP + par * (SC_NB * 320); const LAS float* vvb = VV + par * (SC_NB * 16) + rl; LAS float* ypb = YP + par * (SC_NB * 256) + (w & 3) * 64 + lane;
                const LAS f32x4* op = (const LAS f32x4*)opb + j;
                f32x4 wv = op[0], av = op[16], bv = op[32], kv = op[48], rv = op[64]; float vv = vvb[0];
#pragma unroll
                for (int s = 0; s < SC_NB; ++s) {
                    f32x4 wn, an, bn, kn, rn; float vn;
                    if (s + 1 < SC_NB) { const LAS f32x4* opn = op + (s + 1) * 80; wn = opn[0]; an = opn[16]; bn = opn[32]; kn = opn[48]; rn = opn[64]; vn = vvb[(s + 1) * 16]; }
                    const f32x2 vv2 = {vv, vv};
                    f32x2 t2 = S01 * (f32x2){av[0], av[1]}; t2 = S23 * (f32x2){av[2], av[3]} + t2;
                    float sa = t2[0] + t2[1]; sa = allsum16(sa);
                    const f32x2 sa2 = {sa, sa};
                    const f32x2 T01 = (f32x2){kv[0], kv[1]} * vv2 + S01 * (f32x2){wv[0], wv[1]}, T23 = (f32x2){kv[2], kv[3]} * vv2 + S23 * (f32x2){wv[2], wv[3]};
                    S01 = (f32x2){bv[0], bv[1]} * sa2 + T01;
                    S23 = (f32x2){bv[2], bv[3]} * sa2 + T23;
                    f32x2 y2 = S01 * (f32x2){rv[0], rv[1]}; y2 = S23 * (f32x2){rv[2], rv[3]} + y2;
                    ypb[s * 256] = y2[0] + y2[1];
                    if (s + 1 < SC_NB) { wv = wn; av = an; bv = bn; kv = kn; rv = rn; vv = vn; }
                }
            } else {
                if (it >= 1) SC_YRED(it - 1);
                if (it + 1 < NBATCH) { SC_PREP(1 - par, it + 1); if (it + 3 < NBATCH) SC_LOAD(1 - par, it + 3); }
            }
            __syncthreads();
        }
    }
    __builtin_amdgcn_s_setprio(0);
    if (!is_scan) SC_YRED(NBATCH - 1);
    __syncthreads();
    }
#undef SC_LOAD
#undef SC_PREP
#undef SC_YRED
}

#define XB_TMO      128
#define XB_XCNT(j)  (256  + 64 * (j))
#define XB_XSUB(j)  (1280 + 64 * (j))
#define XB_XGEN(j)  (2304 + 64 * (j))
#define XB_TOP      3328
#define XB_TOPGEN   3392
#define XCD_BAR_WORDS 3456
#define XB_SPIN_CAP (1u << 18)

__device__ __forceinline__ unsigned xb_ld(unsigned* p)              { return __hip_atomic_load(p, __ATOMIC_RELAXED, __HIP_MEMORY_SCOPE_AGENT); }
__device__ __forceinline__ unsigned xb_add(unsigned* p, unsigned v) { return __hip_atomic_fetch_add(p, v, __ATOMIC_RELAXED, __HIP_MEMORY_SCOPE_AGENT); }
__device__ __forceinline__ unsigned xb_xcc_id() { return (unsigned)__builtin_amdgcn_s_getreg((3 << 11) | 20) & 0xFu; }
#define XB_SPIN(cond, bar) do { unsigned _sp = 0; while (cond) { __builtin_amdgcn_s_sleep(1); \
    if ((++_sp & 255u) == 0u) { if (xb_ld(&(bar)[XB_TMO])) break; if (_sp > XB_SPIN_CAP) { atomicAdd(&(bar)[XB_TMO], 1u); break; } } } } while (0)

struct XcdBarrier {
    unsigned* bar; unsigned x;
    volatile LAS unsigned* st;
};

__device__ __forceinline__ XcdBarrier xcd_barrier_post(unsigned* bar, volatile LAS unsigned* st) {
    XcdBarrier b; b.bar = bar; b.x = xb_xcc_id(); b.st = st;
    if (threadIdx.x == 0) (void)xb_add(&bar[XB_XCNT(b.x)], 1u);
    return b;
}
__device__ __forceinline__ void xcd_barrier_complete(unsigned* bar, unsigned x, unsigned& nloc, unsigned& nx) {
    const unsigned G = gridDim.x * gridDim.y * gridDim.z;
    unsigned sum, cnt, mine, sp = 0u;
    for (;;) {
        sum = 0u; cnt = 0u; mine = 0u;
#pragma unroll
        for (unsigned j = 0; j < 16; ++j) { const unsigned c = xb_ld(&bar[XB_XCNT(j)]); sum += c; cnt += (c > 0u) ? 1u : 0u; mine = (j == x) ? c : mine; }
        if (sum == G) break;
        __builtin_amdgcn_s_sleep(1);
        if ((++sp & 255u) == 0u) { if (xb_ld(&bar[XB_TMO])) break; if (sp > XB_SPIN_CAP) { atomicAdd(&bar[XB_TMO], 1u); break; } }
    }
    nloc = mine > 0u ? mine : 1u; nx = cnt > 0u ? cnt : 1u;
}

__device__ __forceinline__ void xcd_barrier(const XcdBarrier& b) {
    asm volatile("s_waitcnt vmcnt(0)" ::: "memory");
    __syncthreads();
    if (threadIdx.x == 0) {
        unsigned* bar = b.bar;
        __builtin_amdgcn_s_waitcnt(0);
        unsigned nloc = b.st[0], nx = b.st[1];
        if (nloc == 0u) { xcd_barrier_complete(bar, b.x, nloc, nx); b.st[0] = nloc; b.st[1] = nx; }
        const unsigned old = xb_add(&bar[XB_XSUB(b.x)], 1u);
        const unsigned gen = old / nloc;
        if (old + 1u == (gen + 1u) * nloc) {
            __builtin_amdgcn_fence(__ATOMIC_RELEASE, "agent");
            asm volatile("s_waitcnt vmcnt(0)" ::: "memory");
            const unsigned og = xb_add(&bar[XB_TOP], 1u);
            const unsigned tg = og / nx;
            if (og + 1u == (tg + 1u) * nx) xb_add(&bar[XB_TOPGEN], 1u);
            else XB_SPIN(xb_ld(&bar[XB_TOPGEN]) == tg, bar);
            __builtin_amdgcn_fence(__ATOMIC_ACQUIRE, "agent");
            xb_add(&bar[XB_XGEN(b.x)], 1u);
            asm volatile("s_waitcnt vmcnt(0)" ::: "memory");
        } else {
            XB_SPIN(xb_ld(&bar[XB_XGEN(b.x)]) == gen, bar);
            __builtin_amdgcn_fence(__ATOMIC_ACQUIRE, "agent");
            asm volatile("s_waitcnt vmcnt(0)" ::: "memory");
        }
    }
    __syncthreads();
}

__device__ __forceinline__ int opaque_int(int n) { asm volatile("" : "+s"(n)); return n; }

__global__ void __launch_bounds__(NWV * 64, 2) mk_fwd(Args a) {
    extern __shared__ __attribute__((aligned(16))) unsigned char lds_raw[];
    LAS unsigned char* lds = (LAS unsigned char*)lds_raw;
    const int tid = threadIdx.x, lane = tid & 63, wave = __builtin_amdgcn_readfirstlane(tid >> 6);
    const int G = gridDim.x, bx = blockIdx.x;
    const int gw = bx * NWV + wave, NGW = G * NWV;
    const int gt = bx * (NWV * 64) + tid, NGT = G * NWV * 64;
    unsigned char* ws = a.ws;
    bf16_t* W1T = (bf16_t*)(ws + OFF_W1T); bf16_t* WLORA = (bf16_t*)(ws + OFF_WLORA); bf16_t* WA = (bf16_t*)(ws + OFF_WA); bf16_t* WB = (bf16_t*)(ws + OFF_WB);
    bf16_t* WOUT = (bf16_t*)(ws + OFF_WOUT); bf16_t* WUP = (bf16_t*)(ws + OFF_WUP); bf16_t* WDN = (bf16_t*)(ws + OFF_WDN); bf16_t* WPG = (bf16_t*)(ws + OFF_WPG); bf16_t* WPLE = (bf16_t*)(ws + OFF_WPLE);
    float* RS0 = (float*)(ws + OFF_RS0); float* RSPA = (float*)(ws + OFF_RSPA); float* RSPB = (float*)(ws + OFF_RSPB); float* RK = (float*)(ws + OFF_RK); float* ALSE = (float*)(ws + OFF_ALSE);
    bf16_t* PB = (bf16_t*)(ws + OFF_PB); bf16_t* XB = (bf16_t*)(ws + OFF_XB); bf16_t* PRW = (bf16_t*)(ws + OFF_PRW); bf16_t* QKV = (bf16_t*)(ws + OFF_QKV);
    bf16_t* LW = (bf16_t*)(ws + OFF_LW); bf16_t* AA = (bf16_t*)(ws + OFF_AA); bf16_t* GG = (bf16_t*)(ws + OFF_GG); bf16_t* ALORA = (bf16_t*)(ws + OFF_ALORA);
    float* YRAW = (float*)(ws + OFF_YRAW); bf16_t* YA = (bf16_t*)(ws + OFF_YA); bf16_t* YB = (bf16_t*)(ws + OFF_YB); bf16_t* MERGED = (bf16_t*)(ws + OFF_MERGED);
    bf16_t* UU = (bf16_t*)(ws + OFF_U); bf16_t* HMID = (bf16_t*)(ws + OFF_HMID); bf16_t* PL = (bf16_t*)(ws + OFF_PL);
    bf16_t* GATE = (bf16_t*)a.out;
    const int lo = a.ph_lo, hi = a.ph_hi;
    XcdBarrier xbar; xbar.bar = (unsigned*)(ws + OFF_CTL); xbar.x = 0; xbar.st = nullptr;
    if (hi - lo > 2) {
        if (tid < 2) ((volatile LAS unsigned*)(lds + 131072 + 512))[tid] = 0u;
        __syncthreads();
        xbar = xcd_barrier_post((unsigned*)(ws + OFF_CTL), (volatile LAS unsigned*)(lds + 131072 + 512));
        cg::this_grid().sync();
    }
#ifndef ONLY_PHASE
#define ONLY_PHASE -1
#endif
#ifndef PROBE_MASK
#define PROBE_MASK 0
#endif
#define REPS(k) ((((PROBE_MASK >> (k)) & 1) != 0) ? opaque_int(2) : 1)
#define IN(k) ((ONLY_PHASE < 0 || ONLY_PHASE == (k) || (ONLY_PHASE == 8 && (k) == 10) || (ONLY_PHASE == 9 && (k) == 11)) && lo <= (k) && (k) < hi)
#if (PROBE_MASK >> 13) & 1
#define SEAM(k) do { if (IN(k) && IN((k) + 1)) { xcd_barrier(xbar); xcd_barrier(xbar); } } while (0)
#else
#define SEAM(k) do { if (IN(k) && IN((k) + 1)) xcd_barrier(xbar); } while (0)
#endif

    if (IN(0)) for (int rep_ = 0; rep_ < REPS(0); ++rep_) {
        LAS float* scr = (LAS float*)(lds + wave * 16384);
        constexpr int I_WIN = 16 * 129, I_WG = 16 * 64;
        for (int it = gw; it < I_WIN + I_WG; it += NGW) {
            int r = it;
            if (r < I_WIN) { const int kb = r / 129, nb = r % 129, n0 = 32 * nb; tr_item(a.in[3], 4128, 64 * kb, n0, a.in[2], W1T, DM, n0 < RWC ? n0 : n0 + 224, scr, lane); continue; } r -= I_WIN;
            { const int kb = r / 64, nb = r % 64; tr_item(a.in[17], 2048, 64 * kb, 32 * nb, a.in[2], W1T, DM, 4352 + 32 * nb, scr, lane); }
        }
        for (int e = gt; e < 224 * DM / 8; e += NGT) *(u32x4*)(W1T + (size_t)RWC * DM + (size_t)e * 8) = (u32x4){0u, 0u, 0u, 0u};
        for (int m0 = gw * 4; m0 < MTOK; m0 += NGW * 4) {
            f32x4 v[4][4];
#pragma unroll
            for (int r = 0; r < 4; ++r) { const f32x4* xr = (const f32x4*)(a.in[0] + (size_t)(m0 + r) * DM) + lane;
#pragma unroll
                for (int jj = 0; jj < 4; ++jj) v[r][jj] = __builtin_nontemporal_load(xr + 64 * jj); }
#pragma unroll
            for (int r = 0; r < 4; ++r) { float sq = 0.f;
#pragma unroll
                for (int jj = 0; jj < 4; ++jj) sq += (v[r][jj][0] * v[r][jj][0] + v[r][jj][1] * v[r][jj][1]) + (v[r][jj][2] * v[r][jj][2] + v[r][jj][3] * v[r][jj][3]);
                sq = wave_sum(sq); if (lane == 0) RS0[m0 + r] = rsqrtf(sq * (1.0f / DM) + NEPS);
                u32x2* o8 = (u32x2*)(XB + (size_t)(m0 + r) * DM) + lane;
#pragma unroll
                for (int jj = 0; jj < 4; ++jj) { u32x2 o; o.x = pk2(v[r][jj][0], v[r][jj][1]); o.y = pk2(v[r][jj][2], v[r][jj][3]); o8[64 * jj] = o; } }
        }
        __syncthreads();
    }
    SEAM(0);
    if (IN(1)) for (int rep_ = 0; rep_ < REPS(1); ++rep_) {
        pg8::Gemm g{XB, W1T, MTOK, N1, DM}; pg8::StaticOrder S; S.init(MTOK, N1, G, bx);
        EpiG1 E{PRW, QKV, GATE, RS0, a.in[18]};
        pg8::gemm_phase<EpiG1, pg8::StaticOrder, true, true>(lds, g, S, E);
        if (bx >= 128 && G == 256) {
            const int gw2 = (bx - 128) * NWV + wave, NGW2 = 128 * NWV, gt2 = (bx - 128) * (NWV * 64) + tid, NGT2 = 128 * NWV * 64;
            LAS float* scr = (LAS float*)(lds + wave * 16384);
            constexpr int I_WA = 8 * 32, I_WB = 4 * 32, I_WO = 16 * 32, I_WUP = 16 * 192, I_WD = 48 * 32, I_WPG = 16 * 32, I_WPLE = 4 * 32;
            constexpr int NIT2 = I_WA + I_WB + I_WO + I_WUP + I_WD + I_WPG + I_WPLE;
            for (int it = gw2; it < NIT2; it += NGW2) {
                int r = it;
                if (r < I_WA) { tr_matrix_item(a.in[15], 512, DM, nullptr, WA, r, scr, lane); continue; } r -= I_WA;
                if (r < I_WB) { tr_matrix_item(a.in[16], 256, DM, nullptr, WB, r, scr, lane); continue; } r -= I_WB;
                if (r < I_WO) { tr_matrix_item(a.in[19], DM, DM, nullptr, WOUT, r, scr, lane); continue; } r -= I_WO;
                if (r < I_WUP) { const int kb = r / 192, nb = r % 192, n0 = 32 * nb, jj = n0 < DFF ? n0 : n0 - DFF;
                    tr_item(a.in[21], 6144, 64 * kb, n0, a.in[20], WUP, DM, (jj / 128) * 256 + (n0 < DFF ? 0 : 128) + (jj % 128), scr, lane); continue; } r -= I_WUP;
                if (r < I_WD) { tr_matrix_item(a.in[24], DFF, DM, nullptr, WDN, r, scr, lane); continue; } r -= I_WD;
                if (r < I_WPG) { tr_matrix_item(a.in[26], DM, DM, a.in[25], WPG, r, scr, lane); continue; } r -= I_WPG;
                tr_matrix_item(a.in[27], 256, DM, nullptr, WPLE, r, scr, lane);
            }
            for (int e = gt2; e < NLORA * KLORA; e += NGT2) { const int n = e / KLORA, k = e % KLORA; float v = 0.f;
                if (n < 512) { if (k < 64) v = a.in[6][k * 512 + n]; } else if (n < 1024) { if (k >= 64 && k < 128) v = a.in[8][(k - 64) * 512 + (n - 512)]; } else { if (k >= 128 && k < 288) v = a.in[9][(k - 128) * 512 + (n - 1024)]; }
                WLORA[e] = (bf16_t)f2bf(v); }
        for (int c0 = gt2; c0 < MTOK * 256 / 8; c0 += NGT2 * 4) {
            f32x4 p0[4], p1[4];
#pragma unroll
            for (int r = 0; r < 4; ++r) { const int c = c0 + r * NGT2; if (c < MTOK * 256 / 8) { const f32x4* pp = (const f32x4*)(a.in[1] + (size_t)c * 8); p0[r] = __builtin_nontemporal_load(pp); p1[r] = __builtin_nontemporal_load(pp + 1); } }
#pragma unroll
            for (int r = 0; r < 4; ++r) { const int c = c0 + r * NGT2; if (c < MTOK * 256 / 8) { u32x4 o; o.x = pk2(p0[r][0], p0[r][1]); o.y = pk2(p0[r][2], p0[r][3]); o.z = pk2(p1[r][0], p1[r][1]); o.w = pk2(p1[r][2], p1[r][3]); *(u32x4*)(PB + (size_t)c * 8) = o; } }
        }
            __syncthreads();
        }
    }
    SEAM(1);
    if (IN(2)) for (int rep_ = 0; rep_ < REPS(2); ++rep_) {
        for (int m = gw; m < MTOK; m += NGW) {
            const int t = m & (SEQ - 1);
            const bf16_t* prow = PRW + (size_t)m * PRW_LD; const bf16_t* qrow = PRW + (size_t)(t > 0 ? m - 1 : m) * PRW_LD;
            const float tm = t > 0 ? 1.f : 0.f;
            u32x4 lc = {0u, 0u, 0u, 0u}, lp = {0u, 0u, 0u, 0u};
            const int c8 = lane * 8;
            const u32x4 kc = *(const u32x4*)(prow + 512 + c8), kp_ = *(const u32x4*)(qrow + 512 + c8);
            if (lane < 36) { lc = *(const u32x4*)(prow + 1536 + 8 * lane); lp = *(const u32x4*)(qrow + 1536 + 8 * lane); }
            {
                float kc8[8], kp8[8]; unpack8(kc, kc8); unpack8(kp_, kp8);
                const f32x4 mk0 = *(const f32x4*)(a.in[4] + 512 + c8), mk1 = *(const f32x4*)(a.in[4] + 512 + c8 + 4), kk0 = *(const f32x4*)(a.in[10] + c8), kk1 = *(const f32x4*)(a.in[10] + c8 + 4);
                float ss = 0.f;
#pragma unroll
                for (int e = 0; e < 8; ++e) { const float muv = e < 4 ? mk0[e] : mk1[e - 4], kkv = e < 4 ? kk0[e] : kk1[e - 4]; const float kk = (kc8[e] + (kp8[e] * tm - kc8[e]) * muv) * kkv; ss += kk * kk; }
                ss = allsum8(ss);
                if ((lane & 7) == 0) RK[(size_t)m * 8 + (lane >> 3)] = rsqrtf(fmaxf(ss, 1e-24f)); }
            if (lane < 36) {
                const int c = 1536 + 8 * lane; float cur[8], prv[8]; unpack8(lc, cur); unpack8(lp, prv);
                const f32x4 mu0 = *(const f32x4*)(a.in[4] + c), mu1 = *(const f32x4*)(a.in[4] + c + 4); float o[8];
#pragma unroll
                for (int e = 0; e < 8; ++e) { const float muv = e < 4 ? mu0[e] : mu1[e - 4]; const float pm = cur[e] + (prv[e] * tm - cur[e]) * muv;
                    o[e] = (c < 1600) ? (1.0f - 2.0f * __builtin_amdgcn_rcpf(1.0f + __expf(2.0f * pm))) : ((c < 1664) ? pm : sigmoidf_(pm)); }
                *(u32x4*)(ALORA + (size_t)m * KLORA + 8 * lane) = pack8(o);
            } else if (lane < 48) *(u32x4*)(ALORA + (size_t)m * KLORA + 8 * lane) = (u32x4){0u, 0u, 0u, 0u};
        }
    }
    SEAM(2);
    if (IN(3)) for (int rep_ = 0; rep_ < REPS(3); ++rep_) {
        pg8::Gemm g{ALORA, WLORA, MTOK, NLORA, KLORA}; pg8::StaticOrder S; S.init(MTOK, NLORA, G, bx);
        EpiLora E{LW, GG, a.in[5], a.in[7]};
        pg8::gemm_phase<EpiLora, pg8::StaticOrder, true, true>(lds, g, S, E);
    }
    SEAM(3);
    if (IN(4)) {
#if (PROBE_MASK >> 14) & 1
        { int ds_ = 0; asm volatile("" : "+s"(ds_)); for (int u = gw; u < 3 * 4096; u += NGW) attn_unit(QKV, ALSE, u, lane, lds + wave * 4096, ds_); }
#endif
        for (int u = gw; u < 3 * 4096; u += NGW) attn_unit(QKV, ALSE, u, lane, lds + wave * 4096);
        __syncthreads();
        scan_block(a, lds, bx, tid);
        __syncthreads();
    }
    SEAM(4);
    if (IN(5)) for (int rep_ = 0; rep_ < REPS(5); ++rep_) {
        for (int m = gw; m < MTOK; m += NGW) {
            const int t = m & (SEQ - 1); const float tm = t > 0 ? 1.f : 0.f;
            const bf16_t* prow = PRW + (size_t)m * PRW_LD + 1024; const bf16_t* qrow = PRW + (size_t)(t > 0 ? m - 1 : m) * PRW_LD + 1024;
            const int c8 = lane * 8, hh = lane >> 3;
            const f32x4 y0 = *(const f32x4*)(YRAW + (size_t)m * 512 + c8), y1 = *(const f32x4*)(YRAW + (size_t)m * 512 + c8 + 4);
            const u32x4 cvw = *(const u32x4*)(prow + c8), pvw = *(const u32x4*)(qrow + c8), gqw = *(const u32x4*)(GG + (size_t)m * 512 + c8);
            const float rk = RSPB[(size_t)m * 8 + hh];
            u32x4 ao0 = {0u, 0u, 0u, 0u}, ao1 = ao0, ao2 = ao0; float l0 = 0.f, l1 = 0.f, l2 = 0.f;
            if (lane < 32) { const bf16_t* qp = QKV + (size_t)m * QKV_LD + c8; ao0 = *(const u32x4*)qp; ao1 = *(const u32x4*)(qp + 256); ao2 = *(const u32x4*)(qp + 512);
                l0 = ALSE[((size_t)0 * MTOK + m) * 4 + hh]; l1 = ALSE[((size_t)1 * MTOK + m) * 4 + hh]; l2 = ALSE[((size_t)2 * MTOK + m) * 4 + hh]; }
            const f32x4 lg0 = *(const f32x4*)(a.in[13] + c8), lg1 = *(const f32x4*)(a.in[13] + c8 + 4), lb0 = *(const f32x4*)(a.in[14] + c8), lb1 = *(const f32x4*)(a.in[14] + c8 + 4);
            const f32x4 mv0 = *(const f32x4*)(a.in[4] + 1024 + c8), mv1 = *(const f32x4*)(a.in[4] + 1024 + c8 + 4);
            float yv[8] = {y0[0], y0[1], y0[2], y0[3], y1[0], y1[1], y1[2], y1[3]}, cv8[8], pv8[8], gq8[8], o[8];
            unpack8(cvw, cv8); unpack8(pvw, pv8); unpack8(gqw, gq8);
            float sm = ((yv[0] + yv[1]) + (yv[2] + yv[3])) + ((yv[4] + yv[5]) + (yv[6] + yv[7])); sm = allsum8(sm);
            const float mean = sm * (1.0f / 64.0f); float sq = 0.f;
#pragma unroll
            for (int e = 0; e < 8; ++e) { yv[e] -= mean; sq += yv[e] * yv[e]; }
            sq = allsum8(sq); const float rstd = rsqrtf(sq * (1.0f / 64.0f) + 64e-5f);
#pragma unroll
            for (int e = 0; e < 8; ++e) { const float lg = e < 4 ? lg0[e] : lg1[e - 4], lb = e < 4 ? lb0[e] : lb1[e - 4], muv = e < 4 ? mv0[e] : mv1[e - 4];
                const float yn = yv[e] * rstd * lg + lb, vv = cv8[e] + (pv8[e] * tm - cv8[e]) * muv; o[e] = (yn + rk * vv) * gq8[e]; }
            *(u32x4*)(YA + (size_t)m * 512 + c8) = pack8(o);
            if (lane < 32) { float a0[8], a1[8], a2[8], ob[8]; unpack8(ao0, a0); unpack8(ao1, a1); unpack8(ao2, a2);
                const float mx = fmaxf(l0, fmaxf(l1, l2)), w0 = exp2f(l0 - mx), w1 = exp2f(l1 - mx), w2 = exp2f(l2 - mx), inv = 1.0f / (w0 + w1 + w2);
#pragma unroll
                for (int e = 0; e < 8; ++e) ob[e] = (w0 * a0[e] + w1 * a1[e] + w2 * a2[e]) * inv;
                *(u32x4*)(YB + (size_t)m * 256 + c8) = pack8(ob); }
        }
    }
    SEAM(5);
    if (IN(6)) for (int rep_ = 0; rep_ < REPS(6); ++rep_) {
        { pg8::Gemm g{YA, WA, MTOK, DM, 512}; pg8::StaticOrder S; S.init(MTOK, DM, G, bx); EpiBranch<0> E{MERGED, GATE};
          pg8::gemm_phase<EpiBranch<0>, pg8::StaticOrder, true, true>(lds, g, S, E); }
        __syncthreads();
        { pg8::Gemm g{YB, WB, MTOK, DM, 256}; pg8::StaticOrder S; S.init(MTOK, DM, G, bx); EpiBranch<1> E{MERGED, GATE};
          pg8::gemm_phase<EpiBranch<1>, pg8::StaticOrder, true, true>(lds, g, S, E); }
    }
    SEAM(6);
    if (IN(7)) for (int rep_ = 0; rep_ < REPS(7); ++rep_) {
        pg8::Gemm g{MERGED, WOUT, MTOK, DM, DM}; pg8::StaticOrder S; S.init(MTOK, DM, G, bx);
        EpiRes<0, false> E{a.in[0], nullptr, XB, RSPA, nullptr, nullptr};
        pg8::gemm_phase<EpiRes<0, false>, pg8::StaticOrder, true, true>(lds, g, S, E);
    }
    SEAM(7);
    if (IN(8)) for (int rep_ = 0; rep_ < REPS(8); ++rep_) {
        pg8::Gemm g{XB, WUP, MTOK, 6144, DM}; pg8::StaticOrder S; S.init(MTOK, 6144, G, bx);
        EpiUpGlu E{HMID, RSPA, a.in[22], a.in[23], (LAS float*)(lds + 131072 + 4096), (float*)(ws + OFF_UA), (float*)(ws + OFF_UB)};
        pg8::gemm_phase<EpiUpGlu, pg8::StaticOrder, true, true>(lds, g, S, E);
    }
    SEAM(8);
    if (IN(9)) {
        const float* UA = (const float*)(ws + OFF_UA); const float* UB = (const float*)(ws + OFF_UB);
        for (int it = gt; it < 128 * 24 * 16; it += NGT) {
            const int c8 = it & 15, pn = (it >> 4) % 24, pm = it / (24 * 16);
            const int tc = pn * 256 + c8 * 8, gc = pn * 128 + c8 * 8;
            const bool first = (pm & 15) == 0;
            float o0[8], o1[8];
#pragma unroll
            for (int hv = 0; hv < 2; ++hv) {
                const float* a0p = UA + ((size_t)pm * 2) * 6144 + tc + hv * 128; const float* b0p = UB + ((size_t)(first ? pm : pm - 1) * 2) * 6144 + tc + hv * 128; const int wc_ = gc + hv * 3072;
                float u0[8], u1[8], um2[8], um1[8], r0[8], r1[8];
#pragma unroll
                for (int e4 = 0; e4 < 2; ++e4) { const f32x4 x0 = *(const f32x4*)(a0p + 4 * e4), x1 = *(const f32x4*)(a0p + 6144 + 4 * e4), y0 = *(const f32x4*)(b0p + 4 * e4), y1 = *(const f32x4*)(b0p + 6144 + 4 * e4);
                    const f32x4 k0 = *(const f32x4*)(a.in[22] + wc_ + 4 * e4), k1 = *(const f32x4*)(a.in[22] + 6144 + wc_ + 4 * e4), k2 = *(const f32x4*)(a.in[22] + 2 * 6144 + wc_ + 4 * e4), kb = *(const f32x4*)(a.in[23] + wc_ + 4 * e4);
#pragma unroll
                    for (int e = 0; e < 4; ++e) { u0[4 * e4 + e] = x0[e]; u1[4 * e4 + e] = x1[e]; um2[4 * e4 + e] = first ? 0.f : y0[e]; um1[4 * e4 + e] = first ? 0.f : y1[e];
                        r0[4 * e4 + e] = kb[e] + k0[e] * x0[e] + k1[e] * um1[4 * e4 + e] + k2[e] * um2[4 * e4 + e];
                        r1[4 * e4 + e] = kb[e] + k0[e] * x1[e] + k1[e] * x0[e] + k2[e] * um1[4 * e4 + e]; } }
#pragma unroll
                for (int e = 0; e < 8; ++e) { if (hv == 0) { o0[e] = gelu_tanh(r0[e]); o1[e] = gelu_tanh(r1[e]); } else { o0[e] *= r0[e]; o1[e] *= r1[e]; } }
            }
            *(u32x4*)(HMID + ((size_t)pm * 256) * DFF + gc) = pack8(o0); *(u32x4*)(HMID + ((size_t)pm * 256 + 1) * DFF + gc) = pack8(o1);
        }
    }
    SEAM(9);
    if (IN(12)) {
        { pg8::Gemm g{HMID, WDN, MTOK, DM, DFF}; pg8::StaticOrder S; S.init(MTOK, DM, G, bx);
          EpiRes<0, true> E{nullptr, XB, XB, RSPB, nullptr, nullptr};
          pg8::gemm_phase<EpiRes<0, true>, pg8::StaticOrder, true, true>(lds, g, S, E); }
        __syncthreads();
        { pg8::Gemm g{PB, WPLE, MTOK, DM, 256}; pg8::StaticOrder S; S.init(MTOK, DM, G, bx); EpiPlain E{PL, DM};
          pg8::gemm_phase<EpiPlain, pg8::StaticOrder, true, true>(lds, g, S, E); }
    }
    SEAM(12);
    if (IN(13)) {
        pg8::Gemm g{XB, WPG, MTOK, DM, DM}; pg8::StaticOrder S; S.init(MTOK, DM, G, bx);
        EpiRes<1, true> E{nullptr, XB, HMID  , RSPA, RSPB, PL};
        pg8::gemm_phase<EpiRes<1, true>, pg8::StaticOrder, true, true>(lds, g, S, E);
    }
    SEAM(13);
    if (IN(14)) {
        for (int m0 = gw * 4; m0 < MTOK; m0 += NGW * 4) {
            u32x2 w[4][4]; float rs[4];
#pragma unroll
            for (int r = 0; r < 4; ++r) { const u32x2* xr = (const u32x2*)(HMID + (size_t)(m0 + r) * DM) + lane;
#pragma unroll
                for (int jj = 0; jj < 4; ++jj) w[r][jj] = xr[64 * jj];
                rs[r] = rstd16(RSPA, m0 + r); }
#pragma unroll
            for (int r = 0; r < 4; ++r) { f32x4* orow = (f32x4*)(a.out + (size_t)(m0 + r) * DM) + lane; const f32x4* gr = (const f32x4*)a.in[28] + lane;
#pragma unroll
                for (int jj = 0; jj < 4; ++jj) { const f32x4 gf = gr[64 * jj]; const f32x4 v = {bflo(w[r][jj].x), bfhi(w[r][jj].x), bflo(w[r][jj].y), bfhi(w[r][jj].y)}; __builtin_nontemporal_store(v * rs[r] * gf, orow + 64 * jj); } }
        }
    }
#undef IN
#undef SEAM
}

extern "C" void kernel_launch(void* const* d_in, const int* in_sizes, int n_in, void* d_out, int out_size, void* d_ws, size_t ws_size, hipStream_t stream) {
    static int grid = 0;
    if (grid == 0) {
        if (n_in != 29 || out_size != MTOK * DM || ws_size < WS_NEED) { fprintf(stderr, "kernel_launch: unexpected shapes (n_in %d out %d ws %zu need %zu)\n", n_in, out_size, ws_size, (size_t)WS_NEED); grid = -1; return; }
        int dev = 0, cus = 0, per_cu = 0;
        hipGetDevice(&dev); hipDeviceGetAttribute(&cus, hipDeviceAttributeMultiprocessorCount, dev);
        if (hipFuncSetAttribute((const void*)mk_fwd, hipFuncAttributeMaxDynamicSharedMemorySize, LDS_BYTES) != hipSuccess) { fprintf(stderr, "kernel_launch: hipFuncSetAttribute failed\n"); grid = -1; return; }
        if (hipOccupancyMaxActiveBlocksPerMultiprocessor(&per_cu, (const void*)mk_fwd, NWV * 64, LDS_BYTES) != hipSuccess || per_cu < 1) { fprintf(stderr, "kernel_launch: occupancy query says %d\n", per_cu); per_cu = 1; }
        (void)hipGetLastError();
        grid = cus * per_cu; if (grid > 256) grid = 256;
        if (grid < 256) fprintf(stderr, "kernel_launch: grid %d < 256\n", grid);
    }
    if (grid < 0) return;
    if (hipMemsetAsync((char*)d_ws + OFF_CTL, 0, CTL_BYTES, stream) != hipSuccess) { fprintf(stderr, "kernel_launch: memset failed\n"); return; }
    Args a{};
    for (int i = 0; i < 29; ++i) a.in[i] = (const float*)d_in[i];
    a.out = (float*)d_out; a.ws = (unsigned char*)d_ws;
#if MK_MULTI
    for (int ph = 0; ph < N_PHASES; ++ph) { a.ph_lo = ph; a.ph_hi = ph + 1; hipLaunchKernelGGL(mk_fwd, dim3(grid), dim3(NWV * 64), LDS_BYTES, stream, a); }
#else
    a.ph_lo = 0; a.ph_hi = N_PHASES;
    void* args[] = {&a};
    hipError_t e = hipLaunchCooperativeKernel((const void*)mk_fwd, dim3(grid), dim3(NWV * 64), args, LDS_BYTES, stream);
    if (e != hipSuccess) fprintf(stderr, "kernel_launch: cooperative launch failed: %s (grid %d)\n", hipGetErrorString(e), grid);
#endif
}
```
